# Optimizing an MI355X kernel written in HIP

```python
import math
import jax, jax.numpy as jnp
from jax import lax
import numpy as np

D_MODEL = 1024
BATCH = 8
SEQ = 4096
DEPTH = 4

HEAD_DIM = 64
N_HEADS = D_MODEL // HEAD_DIM
SWA_KV_HEADS = max(1, N_HEADS // 8)
N_MIXERS = 3
SB_BLOCK = 128
MOBA_BLOCK = 256
MOBA_TOPK = 3
MOBA_QCHUNK = 16
SWA_WINDOW = 128
ROPE_THETA = 10000.0
D_FF = -(-8 * D_MODEL // (3 * 256)) * 256
EPS = 1e-6

kernel_name = "hybrid_sb_moba_swa_adaln_trunk"


def rms_norm(x, gain):
    xf = x.astype(jnp.float32)
    var = jnp.mean(xf * xf, axis=-1, keepdims=True)
    return (xf * lax.rsqrt(var + EPS)).astype(x.dtype) * gain


def modulate(h, shift, scale):
    return h * (1.0 + scale) + shift


def split_heads(t, n):
    b, s, _ = t.shape
    return t.reshape(b, s, n, HEAD_DIM).transpose(0, 2, 1, 3)


def merge_heads(t):
    b, n, s, d = t.shape
    return t.transpose(0, 2, 1, 3).reshape(b, s, n * d)


def rope_tables(seq_len):
    inv_freq = 1.0 / (ROPE_THETA ** (jnp.arange(0, HEAD_DIM, 2, dtype=jnp.float32) / HEAD_DIM))
    ang = jnp.arange(seq_len, dtype=jnp.float32)[:, None] * inv_freq[None, :]
    return jnp.cos(ang), jnp.sin(ang)


def apply_rope(x, cos, sin):
    cos = cos.astype(x.dtype)
    sin = sin.astype(x.dtype)
    x1, x2 = jnp.split(x, 2, axis=-1)
    return jnp.concatenate([x1 * cos - x2 * sin, x2 * cos + x1 * sin], axis=-1)


def stick_breaking_attention(h, w_in, w_out):
    b, s_len, _ = h.shape
    q, k, v = jnp.split(h @ w_in, 3, axis=-1)
    q, k, v = split_heads(q, N_HEADS), split_heads(k, N_HEADS), split_heads(v, N_HEADS)
    nblk = s_len // SB_BLOCK
    q_blocks = q.reshape(b, N_HEADS, nblk, SB_BLOCK, HEAD_DIM).transpose(2, 0, 1, 3, 4)
    k_pos = jnp.arange(s_len)
    scale = HEAD_DIM ** -0.5

    def block(args):
        qb, bi = args
        q_pos = bi * SB_BLOCK + jnp.arange(SB_BLOCK)
        z = jnp.einsum('bhqd,bhkd->bhqk', qb, k).astype(jnp.float32) * scale
        past = k_pos[None, :] < q_pos[:, None]
        log_beta = jax.nn.log_sigmoid(z)
        log_keep = jnp.where(past, jax.nn.log_sigmoid(-z), 0.0)
        later = lax.cumsum(log_keep, axis=3, reverse=True) - log_keep
        a = jnp.where(past, jnp.exp(log_beta + later), 0.0)
        return jnp.einsum('bhqk,bhkd->bhqd', a.astype(v.dtype), v)

    o = lax.map(block, (q_blocks, jnp.arange(nblk)))
    o = o.transpose(1, 2, 0, 3, 4).reshape(b, N_HEADS, s_len, HEAD_DIM)
    return merge_heads(o) @ w_out


def moba_attention(h, w_in, qk_gain, w_out, cos, sin):
    b, s_len, _ = h.shape
    q, k, v = jnp.split(h @ w_in, 3, axis=-1)
    q, k, v = split_heads(q, N_HEADS), split_heads(k, N_HEADS), split_heads(v, N_HEADS)
    q = apply_rope(rms_norm(q, qk_gain[0]), cos, sin)
    k = apply_rope(rms_norm(k, qk_gain[1]), cos, sin)
    pad = (-s_len) % MOBA_BLOCK
    padw = ((0, 0), (0, 0), (0, pad), (0, 0))
    q, k, v = jnp.pad(q, padw), jnp.pad(k, padw), jnp.pad(v, padw)
    s_pad = s_len + pad
    nb = s_pad // MOBA_BLOCK
    topk = min(MOBA_TOPK, nb)
    k_blk = k.reshape(b, N_HEADS, nb, MOBA_BLOCK, HEAD_DIM)
    v_blk = v.reshape(b, N_HEADS, nb, MOBA_BLOCK, HEAD_DIM)
    k_mean = jnp.mean(k_blk.astype(jnp.float32), axis=3).astype(k.dtype)
    n_chunks = s_pad // MOBA_QCHUNK
    q_chunks = q.reshape(b, N_HEADS, n_chunks, MOBA_QCHUNK, HEAD_DIM).transpose(2, 0, 1, 3, 4)
    b_idx = jnp.arange(b)[:, None, None, None]
    h_idx = jnp.arange(N_HEADS)[None, :, None, None]
    blk_ids = jnp.arange(nb)
    in_blk = jnp.arange(MOBA_BLOCK)
    scale = HEAD_DIM ** -0.5

    def chunk(args):
        qc, ci = args
        q_pos = ci * MOBA_QCHUNK + jnp.arange(MOBA_QCHUNK)
        own = (ci * MOBA_QCHUNK) // MOBA_BLOCK
        gate = jnp.einsum('bhqd,bhnd->bhqn', qc, k_mean).astype(jnp.float32)
        gate = jnp.where(blk_ids < own, gate, -jnp.inf)
        top_val, top_idx = lax.top_k(gate, topk)
        sel_ok = jnp.isfinite(top_val)
        kg = k_blk[b_idx, h_idx, top_idx]
        vg = v_blk[b_idx, h_idx, top_idx]
        s_sel = jnp.einsum('bhqd,bhqnkd->bhqnk', qc, kg).astype(jnp.float32) * scale
        s_sel = jnp.where(sel_ok[..., None], s_sel, -jnp.inf)
        k_own = lax.dynamic_slice_in_dim(k, own * MOBA_BLOCK, MOBA_BLOCK, axis=2)
        v_own = lax.dynamic_slice_in_dim(v, own * MOBA_BLOCK, MOBA_BLOCK, axis=2)
        s_own = jnp.einsum('bhqd,bhkd->bhqk', qc, k_own).astype(jnp.float32) * scale
        own_pos = own * MOBA_BLOCK + in_blk
        s_own = jnp.where(own_pos[None, :] <= q_pos[:, None], s_own, -jnp.inf)
        qn = qc.shape[2]
        logits = jnp.concatenate([s_sel.reshape(b, N_HEADS, qn, topk * MOBA_BLOCK), s_own], axis=-1)
        p = jax.nn.softmax(logits, axis=-1).astype(v.dtype)
        p_sel = p[..., :topk * MOBA_BLOCK].reshape(b, N_HEADS, qn, topk, MOBA_BLOCK)
        p_own = p[..., topk * MOBA_BLOCK:]
        return (jnp.einsum('bhqnk,bhqnkd->bhqd', p_sel, vg)
                + jnp.einsum('bhqk,bhkd->bhqd', p_own, v_own))

    o = lax.map(chunk, (q_chunks, jnp.arange(n_chunks)))
    o = o.transpose(1, 2, 0, 3, 4).reshape(b, N_HEADS, s_pad, HEAD_DIM)[:, :, :s_len]
    return merge_heads(o) @ w_out


def swa_sink_attention(h, w_in, qk_gain, sinks, w_out, cos, sin):
    b, s_len, _ = h.shape
    qd, kvd = N_HEADS * HEAD_DIM, SWA_KV_HEADS * HEAD_DIM
    q, k, v = jnp.split(h @ w_in, [qd, qd + kvd], axis=-1)
    q, k, v = split_heads(q, N_HEADS), split_heads(k, SWA_KV_HEADS), split_heads(v, SWA_KV_HEADS)
    q = apply_rope(rms_norm(q, qk_gain[0]), cos, sin)
    k = apply_rope(rms_norm(k, qk_gain[1]), cos, sin)
    w = SWA_WINDOW
    nb = s_len // w
    g = N_HEADS // SWA_KV_HEADS
    qb = q.reshape(b, SWA_KV_HEADS, g, nb, w, HEAD_DIM)

    def band(t):
        tb = t.reshape(b, SWA_KV_HEADS, nb, w, HEAD_DIM)
        prev = jnp.pad(tb, ((0, 0), (0, 0), (1, 0), (0, 0), (0, 0)))[:, :, :-1]
        return jnp.concatenate([prev, tb], axis=3)

    kb, vb = band(k), band(v)
    s = jnp.einsum('bkgnqd,bknsd->bkgnqs', qb, kb).astype(jnp.float32) * (HEAD_DIM ** -0.5)
    q_off = jnp.arange(w)[:, None] + w
    k_off = jnp.arange(2 * w)[None, :]
    rel = q_off - k_off
    in_win = (rel >= 0) & (rel < SWA_WINDOW)
    valid = in_win[None] & ((jnp.arange(nb)[:, None, None] > 0) | (k_off >= w)[None])
    s = jnp.where(valid, s, -jnp.inf)
    sink = sinks.astype(jnp.float32).reshape(SWA_KV_HEADS, g)[None, :, :, None, None, None]
    m = jnp.maximum(jnp.max(s, axis=-1, keepdims=True), sink)
    e = jnp.exp(s - m)
    p = e / (jnp.sum(e, axis=-1, keepdims=True) + jnp.exp(sink - m))
    o = jnp.einsum('bkgnqs,bknsd->bkgnqd', p.astype(v.dtype), vb)
    o = o.reshape(b, N_HEADS, s_len, HEAD_DIM)
    return merge_heads(o) @ w_out


def swiglu(h, w_gate, w_up, w_down):
    return (jax.nn.silu(h @ w_gate) * (h @ w_up)) @ w_down


def setup_inputs(seed: int = 0) -> dict:
    key = jax.random.key(seed)
    ks = jax.random.split(key, 20)
    d = D_MODEL
    hd = N_HEADS * HEAD_DIM
    n_sb, n_moba, n_swa = (DEPTH + 2) // 3, (DEPTH + 1) // 3, DEPTH // 3

    def nrm(k, shape, scale):
        return jax.random.normal(k, shape, jnp.float32) * scale

    return {
        "x": nrm(ks[0], (BATCH, SEQ, d), 1.0),
        "c": nrm(ks[1], (BATCH, d), 1.0),
        "ada_w": nrm(ks[2], (DEPTH, d, 6 * d), 0.5 * d ** -0.5),
        "ada_b": nrm(ks[3], (DEPTH, 6 * d), 0.02),
        "norm_gain": 1.0 + nrm(ks[4], (DEPTH, 2, d), 0.02),
        "ffn_w_gate": nrm(ks[5], (DEPTH, d, D_FF), d ** -0.5),
        "ffn_w_up": nrm(ks[6], (DEPTH, d, D_FF), d ** -0.5),
        "ffn_w_down": nrm(ks[7], (DEPTH, D_FF, d), D_FF ** -0.5),
        "sb_w_in": nrm(ks[8], (n_sb, d, 3 * hd), d ** -0.5),
        "sb_w_out": nrm(ks[9], (n_sb, hd, d), hd ** -0.5),
        "moba_w_in": nrm(ks[10], (n_moba, d, 3 * hd), d ** -0.5),
        "moba_qk_gain": 1.0 + nrm(ks[11], (n_moba, 2, HEAD_DIM), 0.02),
        "moba_w_out": nrm(ks[12], (n_moba, hd, d), hd ** -0.5),
        "swa_w_in": nrm(ks[13], (n_swa, d, (N_HEADS + 2 * SWA_KV_HEADS) * HEAD_DIM), d ** -0.5),
        "swa_qk_gain": 1.0 + nrm(ks[14], (n_swa, 2, HEAD_DIM), 0.02),
        "swa_sinks": nrm(ks[15], (n_swa, N_HEADS), 0.5),
        "swa_w_out": nrm(ks[16], (n_swa, hd, d), hd ** -0.5),
    }


def reference(x, c, ada_w, ada_b, norm_gain, ffn_w_gate, ffn_w_up, ffn_w_down,
              sb_w_in, sb_w_out, moba_w_in, moba_qk_gain, moba_w_out,
              swa_w_in, swa_qk_gain, swa_sinks, swa_w_out):
    s_len = x.shape[1]
    cos, sin = rope_tables(s_len)
    c_act = jax.nn.silu(c)
    for i in range(DEPTH):
        mod = c_act @ ada_w[i] + ada_b[i]
        sh1, sc1, g1, sh2, sc2, g2 = [m[:, None, :] for m in jnp.split(mod, 6, axis=-1)]
        h = modulate(rms_norm(x, norm_gain[i, 0]), sh1, sc1)
        kind, j = i % N_MIXERS, i // N_MIXERS
        if kind == 0:
            y = stick_breaking_attention(h, sb_w_in[j], sb_w_out[j])
        elif kind == 1:
            y = moba_attention(h, moba_w_in[j], moba_qk_gain[j], moba_w_out[j], cos, sin)
        else:
            y = swa_sink_attention(h, swa_w_in[j], swa_qk_gain[j], swa_sinks[j], swa_w_out[j], cos, sin)
        x = x + g1 * y
        h = modulate(rms_norm(x, norm_gain[i, 1]), sh2, sc2)
        x = x + g2 * swiglu(h, ffn_w_gate[i], ffn_w_up[i], ffn_w_down[i])
    return x
```

```cpp
#include <hip/hip_runtime.h>
#include <hip/hip_cooperative_groups.h>
#include <cstdio>
#include <cstdint>
namespace cg = cooperative_groups;
namespace pg8 {
#define PG8_LAS __attribute__((address_space(3)))
typedef unsigned short bf16_t;
typedef short bf16x8 __attribute__((ext_vector_type(8)));
typedef float f32x4 __attribute__((ext_vector_type(4)));
typedef unsigned u32x4 __attribute__((ext_vector_type(4)));
constexpr int BM = 256, BK = 64, HALF = 128, HTB = HALF * BK * 2  , STAGE_BYTES = 8 * HTB, NXCD = 8, WGM = 8;

__host__ __device__ __forceinline__ int lds_byte(int r, int c) { const int st = (r >> 4) * 2 + (c >> 5), rr = r & 15, cc = c & 31, ob = rr * 64 + cc * 2; return st * 1024 + (ob ^ (((ob >> 9) & 1) << 5)); }
__host__ __device__ __forceinline__ void stage_rc(int b, int& R, int& C) { const int st = b / 1024, sb = b % 1024, swz = sb ^ (((sb >> 9) & 1) << 5); R = (st >> 1) * 16 + swz / 64; C = (st & 1) * 32 + (swz % 64) / 2; }
__host__ __device__ __forceinline__ int perm32(int rho) { const int n = rho >> 4, i = rho & 15; return 8 * (i >> 2) + 4 * n + (i & 3); }

struct Unit { int pm, pn; };
struct Gemm { const bf16_t* A; const bf16_t* Bt; int M, N, K; };

struct StaticOrder {
    int nM, nN, nwg, G, c;
    __host__ __device__ void init(int M, int N, int G_, int c_) { nM = M / BM; nN = N / BM; nwg = nM * nN; G = G_; c = c_; }
    __host__ __device__ bool next(int i, Unit& u) const {
        const long L = (long)i * G + c; if (L >= nwg) return false;
        int wgid = (int)L; { const int q = nwg / NXCD, r = nwg % NXCD, xcd = wgid % NXCD, off = wgid / NXCD; wgid = (xcd < r ? xcd * (q + 1) : r * (q + 1) + (xcd - r) * q) + off; }
        const int nig = WGM * nN, gid = wgid / nig, fm = gid * WGM, gsz = (nM - fm) < WGM ? (nM - fm) : WGM;
        u.pm = fm + ((wgid % nig) % gsz); u.pn = (wgid % nig) / gsz; return true;
    }
    __device__ __forceinline__ void a_ready(const Unit&) const {}
    __device__ __forceinline__ void done(const Unit&) const {}
};

__device__ __forceinline__ unsigned cvt_pk_bf16(float lo, float hi) { unsigned r; asm volatile("v_cvt_pk_bf16_f32 %0, %1, %2" : "=v"(r) : "v"(lo), "v"(hi)); return r; }
typedef float f32x2 __attribute__((ext_vector_type(2)));
struct EpiBf16 {
    static constexpr bool PERM = true, AFTER_DRAIN = false;
    bf16_t* O; int ldc;
    __device__ __forceinline__ void operator()(const f32x4 (&acc)[2][2][4][2], const Unit& u, int wr, int wc, int fr, int fq) const {
        const int row0 = u.pm * BM + wr * 64 + fr; const int col0 = u.pn * BM + wc * 32 + 8 * fq;
#pragma unroll
        for (int ai = 0; ai < 2; ++ai)
#pragma unroll
            for (int m = 0; m < 4; ++m) { bf16_t* rowp = O + (size_t)(row0 + ai * HALF + m * 16) * ldc + col0;
#pragma unroll
                for (int bj = 0; bj < 2; ++bj) { const f32x4 v0 = acc[ai][bj][m][0], v1 = acc[ai][bj][m][1];
                    u32x4 w; w.x = cvt_pk_bf16(v0[0], v0[1]); w.y = cvt_pk_bf16(v0[2], v0[3]); w.z = cvt_pk_bf16(v1[0], v1[1]); w.w = cvt_pk_bf16(v1[2], v1[3]);
                    *(u32x4*)(rowp + bj * HALF) = w; } }
    }
};
__device__ __forceinline__ int pi32(int m) { return (m & 19) | ((m & 4) << 1) | ((m & 8) >> 1); }
struct EpiQK {
    static constexpr bool PERM = true, AFTER_DRAIN = false;
    bf16_t* Q; unsigned char* KF; int nkv; const unsigned long long* rowsq; const float* bias; int ldb;
    __device__ __forceinline__ void operator()(const f32x4 (&acc)[2][2][4][2], const Unit& u, int wr, int wc, int fr, int fq) const {
        const int row0 = u.pm * BM + wr * 64 + fr; const int col0 = u.pn * BM + wc * 32 + 8 * fq;
        f32x4 bv[2][2];
        { const float* bp = bias + (size_t)((u.pm * BM) >> 12) * ldb + col0;
#pragma unroll
          for (int bj = 0; bj < 2; ++bj) { bv[bj][0] = *(const f32x4*)(bp + bj * HALF); bv[bj][1] = *(const f32x4*)(bp + bj * HALF + 4); } }
#pragma unroll
        for (int ai = 0; ai < 2; ++ai)
#pragma unroll
            for (int m = 0; m < 4; ++m) { const int row = row0 + ai * HALF + m * 16; const float rstd = __builtin_amdgcn_rsqf((float)rowsq[row] * (1.f / 1024.f / 4294967296.f) + 1e-6f);
#pragma unroll
                for (int bj = 0; bj < 2; ++bj) { const f32x4 v0 = acc[ai][bj][m][0] * rstd + bv[bj][0], v1 = acc[ai][bj][m][1] * rstd + bv[bj][1]; const int col = col0 + bj * HALF;
                    u32x4 w; w.x = cvt_pk_bf16(v0[0], v0[1]); w.y = cvt_pk_bf16(v0[2], v0[3]); w.z = cvt_pk_bf16(v1[0], v1[1]); w.w = cvt_pk_bf16(v1[2], v1[3]);
                    if (col < 1024) *(u32x4*)(Q + (size_t)row * 1024 + col) = w;
                    else { const int kc = col - 1024, head = kc >> 6, c = (kc & 63) >> 3;
                        if (head < nkv) { const int b = row >> 12, s = row & 4095;
                            *(u32x4*)(KF + ((size_t)((b * nkv + head) * 128 + (s >> 5)) << 12) + (c >> 1) * 1024 + ((c & 1) * 32 + pi32(s & 31)) * 16) = w; } } } }
    }
};
struct EpiVT {
    static constexpr bool PERM = true, AFTER_DRAIN = false;
    unsigned char* VF; int nkv; int row_off; const unsigned long long* rowsq; const float* bias; int ldb;
    __device__ __forceinline__ void operator()(const f32x4 (&acc)[2][2][4][2], const Unit& u, int wr, int wc, int fr, int fq) const {
        const int row0 = u.pm * BM + wr * 64 + fr - row_off; const int col0 = u.pn * BM + wc * 32 + 8 * fq;
        f32x4 r0[2], r1[2];
#pragma unroll
        for (int bj = 0; bj < 2; ++bj) { const unsigned long long* rp = rowsq + col0 + bj * HALF;
#pragma unroll
            for (int e = 0; e < 4; ++e) { r0[bj][e] = __builtin_amdgcn_rsqf((float)rp[e] * (1.f / 1024.f / 4294967296.f) + 1e-6f); r1[bj][e] = __builtin_amdgcn_rsqf((float)rp[4 + e] * (1.f / 1024.f / 4294967296.f) + 1e-6f); } }
#pragma unroll
        for (int ai = 0; ai < 2; ++ai)
#pragma unroll
            for (int m = 0; m < 4; ++m) { const int f = row0 + ai * HALF + m * 16; if (f < 0) continue; const int kvh = f >> 6, d = f & 63;
#pragma unroll
                for (int bj = 0; bj < 2; ++bj) { const int col = col0 + bj * HALF; const float bs = bias[(size_t)(col >> 12) * ldb + f + row_off];
                    const f32x4 v0 = acc[ai][bj][m][0] * r0[bj] + bs, v1 = acc[ai][bj][m][1] * r1[bj] + bs;
                    u32x4 w; w.x = cvt_pk_bf16(v0[0], v0[1]); w.y = cvt_pk_bf16(v0[2], v0[3]); w.z = cvt_pk_bf16(v1[0], v1[1]); w.w = cvt_pk_bf16(v1[2], v1[3]);
                    const int b = col >> 12, s = col & 4095, x = (s & 31) >> 3;
                    *(u32x4*)(VF + ((size_t)((b * nkv + kvh) * 128 + (s >> 5)) << 12) + ((d >> 5) * 2 + (x >> 1)) * 1024 + ((x & 1) * 32 + (d & 31)) * 16) = w; } }
    }
};
struct EpiRes {
    static constexpr bool PERM = true, AFTER_DRAIN = false;
    const bf16_t* xs_in; const float* gain_c; const float* sc_c; const float* gate; float* fout; bf16_t* xs; const float* gain_n; const float* sc_n; unsigned long long* rowsq;
    __device__ __forceinline__ void operator()(const f32x4 (&acc)[2][2][4][2], const Unit& u, int wr, int wc, int fr, int fq) const {
        const int row0 = u.pm * BM + wr * 64 + fr; const int col0 = u.pn * BM + wc * 32 + 8 * fq;
        const int x32 = ((fq * 16 + fr) ^ 32) << 2; const int bb = (u.pm * BM) >> 12;
        float ssq[8];
#pragma unroll
        for (int i = 0; i < 8; ++i) ssq[i] = 0.f;
#pragma unroll
        for (int bj = 0; bj < 2; ++bj) { const int col = col0 + bj * HALF;
            const f32x4 g0 = *(const f32x4*)(gate + (size_t)bb * 6144 + col), g1 = *(const f32x4*)(gate + (size_t)bb * 6144 + col + 4);
            f32x4 c0 = *(const f32x4*)(gain_c + col) * (*(const f32x4*)(sc_c + (size_t)bb * 6144 + col) + 1.f), c1 = *(const f32x4*)(gain_c + col + 4) * (*(const f32x4*)(sc_c + (size_t)bb * 6144 + col + 4) + 1.f);
#pragma unroll
            for (int e = 0; e < 4; ++e) { c0[e] = __builtin_amdgcn_rcpf(c0[e]); c1[e] = __builtin_amdgcn_rcpf(c1[e]); }
            f32x4 n0 = c0, n1 = c1;
            if (xs) { n0 = *(const f32x4*)(gain_n + col) * (*(const f32x4*)(sc_n + (size_t)bb * 6144 + col) + 1.f); n1 = *(const f32x4*)(gain_n + col + 4) * (*(const f32x4*)(sc_n + (size_t)bb * 6144 + col + 4) + 1.f); }
#pragma unroll
            for (int ai = 0; ai < 2; ++ai)
#pragma unroll
                for (int m = 0; m < 4; ++m) { const size_t e0 = (size_t)(row0 + ai * HALF + m * 16) * 1024 + col;
                    const u32x4 r = *(const u32x4*)(xs_in + e0);
                    const f32x4 x0 = (f32x4){__builtin_bit_cast(float, r.x << 16), __builtin_bit_cast(float, r.x & 0xffff0000u), __builtin_bit_cast(float, r.y << 16), __builtin_bit_cast(float, r.y & 0xffff0000u)} * c0;
                    const f32x4 x1 = (f32x4){__builtin_bit_cast(float, r.z << 16), __builtin_bit_cast(float, r.z & 0xffff0000u), __builtin_bit_cast(float, r.w << 16), __builtin_bit_cast(float, r.w & 0xffff0000u)} * c1;
                    const f32x4 y0 = x0 + g0 * acc[ai][bj][m][0], y1 = x1 + g1 * acc[ai][bj][m][1];
                    if (fout) { *(f32x4*)(fout + e0) = y0; *(f32x4*)(fout + e0 + 4) = y1; }
                    if (xs) { const f32x4 z0 = y0 * n0, z1 = y1 * n1;
                        u32x4 w; w.x = cvt_pk_bf16(z0[0], z0[1]); w.y = cvt_pk_bf16(z0[2], z0[3]); w.z = cvt_pk_bf16(z1[0], z1[1]); w.w = cvt_pk_bf16(z1[2], z1[3]);
                        *(u32x4*)(xs + e0) = w;
                        ssq[ai * 4 + m] += (y0[0] * y0[0] + y0[1] * y0[1]) + (y0[2] * y0[2] + y0[3] * y0[3]) + (y1[0] * y1[0] + y1[1] * y1[1]) + (y1[2] * y1[2] + y1[3] * y1[3]); } } }
        if (xs) {
#pragma unroll
            for (int i = 0; i < 8; ++i) { float q = ssq[i];
                q += __builtin_bit_cast(float, __builtin_amdgcn_ds_swizzle(__builtin_bit_cast(int, q), (16 << 10) | 0x1f));
                q += __builtin_bit_cast(float, __builtin_amdgcn_ds_bpermute(x32, __builtin_bit_cast(int, q)));
                if (fq == 0) atomicAdd(rowsq + row0 + (i >> 2) * HALF + (i & 3) * 16, (unsigned long long)(q * 4294967296.f)); } }
    }
};
struct EpiGLU {
    static constexpr bool PERM = false, AFTER_DRAIN = false;
    bf16_t* O; int ldc; const unsigned long long* rowsq; const float* bias;
    __device__ __forceinline__ void operator()(const f32x4 (&acc)[2][2][4][2], const Unit& u, int wr, int wc, int fr, int fq) const {
        const int row0 = u.pm * BM + wr * 64 + fr; const int col0 = u.pn * 128 + wc * 16 + 4 * fq; const int bcol0 = u.pn * BM + wc * 32 + 4 * fq;
        f32x4 bv[2][2];
        { const float* bp = bias + (size_t)((u.pm * BM) >> 12) * 5632 + bcol0;
#pragma unroll
          for (int bj = 0; bj < 2; ++bj) { bv[bj][0] = *(const f32x4*)(bp + bj * HALF); bv[bj][1] = *(const f32x4*)(bp + bj * HALF + 16); } }
#pragma unroll
        for (int ai = 0; ai < 2; ++ai)
#pragma unroll
            for (int m = 0; m < 4; ++m) { const int row = row0 + ai * HALF + m * 16; bf16_t* rowp = O + (size_t)row * ldc + col0;
                const float rstd = __builtin_amdgcn_rsqf((float)rowsq[row] * (1.f / 1024.f / 4294967296.f) + 1e-6f);
#pragma unroll
                for (int bj = 0; bj < 2; ++bj) { const f32x4 g = acc[ai][bj][m][0] * rstd + bv[bj][0], up = acc[ai][bj][m][1] * rstd + bv[bj][1]; float r[4];
#pragma unroll
                    for (int e = 0; e < 4; ++e) r[e] = __fdividef(g[e], 1.f + __expf(-g[e])) * up[e];
                    uint2 w; w.x = cvt_pk_bf16(r[0], r[1]); w.y = cvt_pk_bf16(r[2], r[3]);
                    *(uint2*)(rowp + bj * 64) = w; } }
    }
};
template <class Epi, class Sched, bool ALIGN_EPI = false, bool SP2 = false>
__device__ __forceinline__ void gemm_phase(PG8_LAS unsigned char* lds, const Gemm g, const Sched& S, const Epi& E, const int wave_s) {
    int lid_; asm volatile("v_mbcnt_lo_u32_b32 %0, -1, 0\n\tv_mbcnt_hi_u32_b32 %0, -1, %0" : "=v"(lid_)); const int tid_ = wave_s * 64 + lid_;
    const int tid = tid_, wid = __builtin_amdgcn_readfirstlane(tid >> 6), lane = tid & 63, wr = wid >> 2, wc = wid & 3, fr = lane & 15, fq = lane >> 4;
    const int K = g.K, nt = K / BK;
    unsigned voffA[2], voffB[2];
#pragma unroll
    for (int i = 0; i < 2; ++i) { int R, C; stage_rc(tid * 16 + i * 8192, R, C); const int Rb = Epi::PERM ? ((R & ~31) + perm32(R & 31)) : R;
        voffA[i] = (unsigned)(R * K + C) * 2u; voffB[i] = (unsigned)(Rb * K + C) * 2u; }
    const size_t kstep = (size_t)(BK * 2);
    const size_t hstep = (size_t)HALF * K * 2;
    const size_t tstep = 2 * hstep;
    const unsigned ldsw = (unsigned)wid * 1024u;
    const int aoff = lds_byte(wr * 64 + fr, fq * 8), boff = lds_byte(wc * 32 + fr, fq * 8);
#define PG8_SA(b, h) (((b) * 2 + (h)) * HTB)
#define PG8_SB(b, h) ((4 + (b) * 2 + (h)) * HTB)
#define PG8_STAGE(bufoff, gbase, voff) do { _Pragma("unroll") for (int _i = 0; _i < 2; ++_i) \
        __builtin_amdgcn_global_load_lds((const unsigned*)((const char*)(gbase) + (voff)[_i]), (PG8_LAS unsigned*)(lds + (bufoff) + ldsw + _i * 8192), 16, 0, 0); } while (0)
#define PG8_LDA(dst, b, h) do { _Pragma("unroll") for (int m = 0; m < 4; ++m) _Pragma("unroll") for (int k = 0; k < 2; ++k) dst[m][k] = *(const PG8_LAS bf16x8*)(lds + PG8_SA(b, h) + aoff + m * 2048 + k * 1024); } while (0)
#define PG8_LDB(dst, b, h) do { _Pragma("unroll") for (int n = 0; n < 2; ++n) _Pragma("unroll") for (int k = 0; k < 2; ++k) dst[n][k] = *(const PG8_LAS bf16x8*)(lds + PG8_SB(b, h) + boff + n * 2048 + k * 1024); } while (0)
#define PG8_MMA(ai, bj, At, Bt) do { __builtin_amdgcn_s_setprio(1); _Pragma("unroll") for (int m = 0; m < 4; ++m) _Pragma("unroll") for (int n = 0; n < 2; ++n) _Pragma("unroll") for (int k = 0; k < 2; ++k) \
        acc[ai][bj][m][n] = __builtin_amdgcn_mfma_f32_16x16x32_bf16(Bt[n][k], At[m][k], acc[ai][bj][m][n], 0, 0, 0); __builtin_amdgcn_s_setprio(0); } while (0)
#define PG8_WAIT_V(n) asm volatile("s_waitcnt vmcnt(" #n ")" ::: "memory")
#define PG8_WAIT_L(n) asm volatile("s_waitcnt lgkmcnt(" #n ")" ::: "memory")
#define PG8_BAR __builtin_amdgcn_s_barrier()
#define PG8_SCHED __builtin_amdgcn_sched_barrier(0)
    Unit cur, nxt; int ui = 0;
    if (!S.next(0, cur)) return;
    f32x4 acc[2][2][4][2];
#pragma unroll
    for (int a = 0; a < 2; ++a)
#pragma unroll
        for (int b = 0; b < 2; ++b)
#pragma unroll
            for (int m = 0; m < 4; ++m)
#pragma unroll
                for (int n = 0; n < 2; ++n) acc[a][b][m][n] = (f32x4){0.f, 0.f, 0.f, 0.f};
    bf16x8 At[4][2], B0[2][2], B1[2][2];
    const char* cA = (const char*)g.A + (size_t)cur.pm * tstep; const char* cB = (const char*)g.Bt + (size_t)cur.pn * tstep;
    S.a_ready(cur);
    if constexpr (SP2) {
        PG8_STAGE(PG8_SB(0, 0), cB, voffB); PG8_STAGE(PG8_SB(0, 1), cB + hstep, voffB); PG8_STAGE(PG8_SA(0, 0), cA, voffA); PG8_STAGE(PG8_SA(0, 1), cA + hstep, voffA);
        if (wr == 1) PG8_BAR;
        PG8_WAIT_V(2); PG8_BAR;
        PG8_STAGE(PG8_SB(1, 0), cB + kstep, voffB); PG8_STAGE(PG8_SA(1, 0), cA + kstep, voffA); PG8_STAGE(PG8_SB(1, 1), cB + hstep + kstep, voffB);
        PG8_WAIT_V(6); PG8_BAR;
    } else {
        PG8_STAGE(PG8_SB(0, 0), cB, voffB); PG8_STAGE(PG8_SA(0, 0), cA, voffA); PG8_STAGE(PG8_SB(0, 1), cB + hstep, voffB); PG8_STAGE(PG8_SA(0, 1), cA + hstep, voffA);
        if (wr == 1) PG8_BAR;
        PG8_WAIT_V(4); PG8_BAR;
        PG8_STAGE(PG8_SB(1, 0), cB + kstep, voffB); PG8_STAGE(PG8_SA(1, 0), cA + kstep, voffA); PG8_STAGE(PG8_SB(1, 1), cB + hstep + kstep, voffB);
        PG8_WAIT_V(6); PG8_BAR;
    }
    for (;;) {
        const bool has_next = S.next(ui + 1, nxt);
        const char* nA = has_next ? (const char*)g.A + (size_t)nxt.pm * tstep : cA; const char* nB = has_next ? (const char*)g.Bt + (size_t)nxt.pn * tstep : cB;
        for (int t = 0; t < nt; t += 2) {
            const bool last = (t == nt - 2);
            const char* a1 = cA + (size_t)(t + 1) * kstep;
            const char* a2 = last ? nA : cA + (size_t)(t + 2) * kstep; const char* b2 = last ? nB : cB + (size_t)(t + 2) * kstep;
            const char* a3 = a2 + kstep; const char* b3 = b2 + kstep;
            if (last && has_next) S.a_ready(nxt);
            if constexpr (SP2) {
            PG8_LDB(B0, 0, 0); PG8_LDB(B1, 0, 1); PG8_SCHED; PG8_LDA(At, 0, 0); PG8_STAGE(PG8_SA(1, 1), a1 + hstep, voffA);
            PG8_WAIT_V(8); PG8_WAIT_L(0); PG8_BAR; PG8_MMA(0, 0, At, B0); PG8_MMA(0, 1, At, B1); PG8_BAR; PG8_SCHED;
            PG8_LDA(At, 0, 1); PG8_STAGE(PG8_SB(0, 0), b2, voffB); PG8_STAGE(PG8_SB(0, 1), b2 + hstep, voffB); PG8_STAGE(PG8_SA(0, 0), a2, voffA);
            PG8_WAIT_V(8); PG8_WAIT_L(0); PG8_BAR; PG8_MMA(1, 0, At, B0); PG8_MMA(1, 1, At, B1); PG8_BAR; PG8_SCHED;
            PG8_LDB(B0, 1, 0); PG8_LDB(B1, 1, 1); PG8_SCHED; PG8_LDA(At, 1, 0); PG8_STAGE(PG8_SA(0, 1), a2 + hstep, voffA);
            PG8_WAIT_V(8); PG8_WAIT_L(0); PG8_BAR; PG8_MMA(0, 0, At, B0); PG8_MMA(0, 1, At, B1); PG8_BAR; PG8_SCHED;
            PG8_LDA(At, 1, 1); PG8_STAGE(PG8_SB(1, 0), b3, voffB); PG8_STAGE(PG8_SB(1, 1), b3 + hstep, voffB); PG8_STAGE(PG8_SA(1, 0), a3, voffA);
            PG8_WAIT_V(8); PG8_WAIT_L(0); PG8_BAR; PG8_MMA(1, 0, At, B0); PG8_MMA(1, 1, At, B1); PG8_BAR; PG8_SCHED;
            } else {
            PG8_LDB(B0, 0, 0); PG8_SCHED; PG8_LDA(At, 0, 0); PG8_STAGE(PG8_SA(1, 1), a1 + hstep, voffA);
            PG8_WAIT_L(8); PG8_BAR; PG8_WAIT_L(0); PG8_MMA(0, 0, At, B0); PG8_BAR; PG8_SCHED;
            PG8_LDB(B1, 0, 1); PG8_STAGE(PG8_SB(0, 0), b2, voffB);
            PG8_BAR; PG8_WAIT_L(0); PG8_MMA(0, 1, At, B1); PG8_BAR;
            PG8_LDA(At, 0, 1); PG8_STAGE(PG8_SA(0, 0), a2, voffA);
            PG8_BAR; PG8_WAIT_L(0); PG8_MMA(1, 0, At, B0); PG8_BAR; PG8_SCHED;
            PG8_STAGE(PG8_SB(0, 1), b2 + hstep, voffB);
            PG8_WAIT_V(6); PG8_BAR; PG8_MMA(1, 1, At, B1); PG8_BAR;
            PG8_LDB(B0, 1, 0); PG8_SCHED; PG8_LDA(At, 1, 0); PG8_STAGE(PG8_SA(0, 1), a2 + hstep, voffA);
            PG8_WAIT_L(8); PG8_BAR; PG8_WAIT_L(0); PG8_MMA(0, 0, At, B0); PG8_BAR; PG8_SCHED;
            PG8_LDB(B1, 1, 1); PG8_STAGE(PG8_SB(1, 0), b3, voffB);
            PG8_BAR; PG8_WAIT_L(0); PG8_MMA(0, 1, At, B1); PG8_BAR;
            PG8_LDA(At, 1, 1); PG8_STAGE(PG8_SA(1, 0), a3, voffA);
            PG8_BAR; PG8_WAIT_L(0); PG8_MMA(1, 0, At, B0); PG8_BAR; PG8_SCHED;
            PG8_STAGE(PG8_SB(1, 1), b3 + hstep, voffB);
            PG8_WAIT_V(6); PG8_BAR; PG8_MMA(1, 1, At, B1); PG8_BAR;
            }
        }
        if constexpr (ALIGN_EPI) { if (wr == 0) PG8_BAR; }
        if constexpr (!Epi::AFTER_DRAIN) { E(acc, cur, wr, wc, fr, fq); S.done(cur); }
        if (!has_next) break;
#pragma unroll
        for (int a = 0; a < 2; ++a)
#pragma unroll
            for (int b = 0; b < 2; ++b)
#pragma unroll
                for (int m = 0; m < 4; ++m)
#pragma unroll
                    for (int n = 0; n < 2; ++n) acc[a][b][m][n] = (f32x4){0.f, 0.f, 0.f, 0.f};
        cur = nxt; cA = nA; cB = nB; ++ui;
        if constexpr (ALIGN_EPI) { if (wr == 1) PG8_BAR; }
    }
    PG8_WAIT_V(0);
    if constexpr (!ALIGN_EPI) { if (wr == 0) PG8_BAR; }
    PG8_BAR;
    if constexpr (Epi::AFTER_DRAIN) { E.fused(acc, cur, wr, wc, fr, fq, lds, wid, lane); S.done(cur); }
#undef PG8_SA
#undef PG8_SB
#undef PG8_STAGE
#undef PG8_LDA
#undef PG8_LDB
#undef PG8_MMA
#undef PG8_WAIT_V
#undef PG8_WAIT_L
#undef PG8_BAR
#undef PG8_SCHED
}
}
constexpr int NB = 8, SEQ = 4096, DM = 1024, NH = 16, HD = 64, FF = 2816, MTOK = NB * SEQ, DEPTH = 4;
constexpr int NWAVES = 8, NTHREADS = 512;
constexpr int LDS_BYTES = 147456;
constexpr float EPS = 1e-6f;
constexpr size_t MiB = 1u << 20;
constexpr size_t WS_MOD = 0;
constexpr size_t WS_KMEAN = 1 * MiB;
constexpr size_t WS_W = 2 * MiB, W_LAYER = 25 * MiB;
constexpr size_t W_IN = 0, W_OUT = 6 * MiB, W_GU = 8 * MiB, W_DN = 19 * MiB;
constexpr size_t WS_H = 104 * MiB;
constexpr size_t WS_O = 168 * MiB;
constexpr size_t WS_QK = 232 * MiB;
constexpr size_t WS_KF = 296 * MiB;
constexpr size_t WS_VT = 360 * MiB;
constexpr size_t WS_ACT = 232 * MiB;
constexpr size_t WS_RSQ = 424 * MiB;
constexpr size_t WS_BIAS = 426 * MiB;
constexpr size_t BIAS_LAYER = 8 * (3072 + 5632) * 4;
constexpr size_t WS_END = 430 * MiB;
static_assert(WS_ACT + (size_t)MTOK * FF * 2 <= WS_END && W_DN + (size_t)DM * FF * 2 <= W_LAYER, "ws map");

#define GAS __attribute__((address_space(1)))
#define LAS __attribute__((address_space(3)))
#define DI __device__ __forceinline__
#define PHASE_IDS() int lane_; asm volatile("v_mbcnt_lo_u32_b32 %0, -1, 0\n\tv_mbcnt_hi_u32_b32 %0, -1, %0" : "=v"(lane_)); const int lane = lane_, wave = wave_s; int gw_ = (int)blockIdx.x * NWAVES + wave; asm volatile("" : "+s"(gw_)); const int gw = gw_; const int x32 = (lane ^ 32) << 2; (void)gw; (void)lane; (void)x32
typedef unsigned short bf16;
typedef unsigned v4u __attribute__((ext_vector_type(4)));
typedef float f32x4 __attribute__((ext_vector_type(4)));
typedef float f32x16 __attribute__((ext_vector_type(16)));
typedef short bf16x8 __attribute__((ext_vector_type(8)));
typedef __bf16 bf16x2_t __attribute__((ext_vector_type(2)));
typedef float f32x2_t __attribute__((ext_vector_type(2)));
#define LDS_WAIT() asm volatile("s_waitcnt lgkmcnt(0)" ::: "memory")
constexpr float SC2 = 0.125f * 1.4426950408889634f;
#define MFMA32(a, b, c) __builtin_amdgcn_mfma_f32_32x32x16_bf16((a), (b), (c), 0, 0, 0)
DI unsigned cvtpk(float lo, float hi) { f32x2_t v = {lo, hi}; bf16x2_t b = __builtin_convertvector(v, bf16x2_t); return __builtin_bit_cast(unsigned, b); }
DI float bf2f(unsigned short u) { return __builtin_bit_cast(float, (unsigned)u << 16); }
template <int MASK> DI float swz_xor(float v) { return __builtin_bit_cast(float, __builtin_amdgcn_ds_swizzle(__builtin_bit_cast(int, v), (MASK << 10) | 0x1f)); }
DI float bperm(float v, int x32) { return __builtin_bit_cast(float, __builtin_amdgcn_ds_bpermute(x32, __builtin_bit_cast(int, v))); }
DI int bperm_i(int v, int x32) { return __builtin_amdgcn_ds_bpermute(x32, v); }
DI float wave_sum(float v, int x32) {
    v += swz_xor<1>(v); v += swz_xor<2>(v); v += swz_xor<4>(v); v += swz_xor<8>(v); v += swz_xor<16>(v); v += bperm(v, x32);
    return v;
}

#define RLX_AGENT __ATOMIC_RELAXED, __HIP_MEMORY_SCOPE_AGENT
constexpr size_t WS_BAR = 1536 * 1024;
constexpr int MISC_OFF = 131072 + 320;
#define XB_TMO      128
#define XB_XCNT(j)  (256  + 64 * (j))
#define XB_XSUB(j)  (1280 + 64 * (j))
#define XB_XGEN(j)  (2304 + 64 * (j))
#define XB_TOP      3328
#define XB_TOPGEN   3392
#define XCD_BAR_WORDS 3456
#define XB_SPIN_CAP (1u << 18)

__device__ __forceinline__ unsigned xb_ld(unsigned* p)              { return __hip_atomic_load(p, __ATOMIC_RELAXED, __HIP_MEMORY_SCOPE_AGENT); }
__device__ __forceinline__ unsigned xb_add(unsigned* p, unsigned v) { return __hip_atomic_fetch_add(p, v, __ATOMIC_RELAXED, __HIP_MEMORY_SCOPE_AGENT); }
__device__ __forceinline__ unsigned xb_xcc_id() { return (unsigned)__builtin_amdgcn_s_getreg((3 << 11) | 20) & 0xFu; }
#define XB_SPIN(cond, bar) do { unsigned _sp = 0; while (cond) { __builtin_amdgcn_s_sleep(1); \
    if ((++_sp & 255u) == 0u) { if (xb_ld(&(bar)[XB_TMO])) break; if (_sp > XB_SPIN_CAP) { atomicAdd(&(bar)[XB_TMO], 1u); break; } } } } while (0)

struct XcdBarrier {
    unsigned* bar; unsigned x;
    volatile LAS unsigned* st;
};

__device__ __forceinline__ XcdBarrier xcd_barrier_post(unsigned* bar, volatile LAS unsigned* st) {
    XcdBarrier b; b.bar = bar; b.x = xb_xcc_id(); b.st = st;
    if (threadIdx.x == 0) (void)xb_add(&bar[XB_XCNT(b.x)], 1u);
    return b;
}
__device__ __forceinline__ void xcd_barrier_complete(unsigned* bar, unsigned x, unsigned& nloc, unsigned& nx) {
    const unsigned G = gridDim.x * gridDim.y * gridDim.z;
    unsigned sum, cnt, mine, sp = 0u;
    for (;;) {
        sum = 0u; cnt = 0u; mine = 0u;
#pragma unroll
        for (unsigned j = 0; j < 16; ++j) { const unsigned c = xb_ld(&bar[XB_XCNT(j)]); sum += c; cnt += (c > 0u) ? 1u : 0u; mine = (j == x) ? c : mine; }
        if (sum == G) break;
        __builtin_amdgcn_s_sleep(1);
        if ((++sp & 255u) == 0u) { if (xb_ld(&bar[XB_TMO])) break; if (sp > XB_SPIN_CAP) { atomicAdd(&bar[XB_TMO], 1u); break; } }
    }
    nloc = mine > 0u ? mine : 1u; nx = cnt > 0u ? cnt : 1u;
}

__device__ __forceinline__ void xcd_barrier(const XcdBarrier& b, const bool leader) {
    asm volatile("s_waitcnt vmcnt(0)" ::: "memory");
    __syncthreads();
    if (leader) {
        unsigned* bar = b.bar; unsigned bx = b.x; asm volatile("" : "+s"(bx), "+s"(bar));
        __builtin_amdgcn_s_waitcnt(0);
        unsigned nloc = b.st[0], nx = b.st[1];
        if (nloc == 0u) { xcd_barrier_complete(bar, bx, nloc, nx); b.st[0] = nloc; b.st[1] = nx; }
        const unsigned old = xb_add(&bar[XB_XSUB(bx)], 1u);
        const unsigned gen = old / nloc;
        if (old + 1u == (gen + 1u) * nloc) {
            __builtin_amdgcn_fence(__ATOMIC_RELEASE, "agent");
            asm volatile("s_waitcnt vmcnt(0)" ::: "memory");
            const unsigned og = xb_add(&bar[XB_TOP], 1u);
            const unsigned tg = og / nx;
            if (og + 1u == (tg + 1u) * nx) xb_add(&bar[XB_TOPGEN], 1u);
            else XB_SPIN(xb_ld(&bar[XB_TOPGEN]) == tg, bar);
            __builtin_amdgcn_fence(__ATOMIC_ACQUIRE, "agent");
            xb_add(&bar[XB_XGEN(bx)], 1u);
            asm volatile("s_waitcnt vmcnt(0)" ::: "memory");
        } else {
            XB_SPIN(xb_ld(&bar[XB_XGEN(bx)]) == gen, bar);
            __builtin_amdgcn_fence(__ATOMIC_ACQUIRE, "agent");
            asm volatile("s_waitcnt vmcnt(0)" ::: "memory");
        }
    }
    __syncthreads();
}

struct Params {
    const float *x, *c, *ada_w, *ada_b, *norm_gain, *ffn_g, *ffn_u, *ffn_d, *sb_in, *sb_out, *moba_in, *moba_gain, *moba_out, *swa_in, *swa_gain, *swa_sinks, *swa_out;
    float* out; unsigned char* ws;
};

typedef const Params __attribute__((address_space(4))) CParams;
DI CParams* kp_opaque() { CParams* r = (CParams*)__builtin_amdgcn_kernarg_segment_ptr(); asm volatile("" : "+s"(r)); return r; }
#define KP() kp_opaque()
DI void transpose_item(const float* W, int K, int N, bf16* WT, int mode, LAS float* scr, int kb, int nb, int lane) {
    const int k0 = 64 * kb, n0 = 32 * nb;
    {
        const int ks = lane >> 3, n4 = (lane & 7) * 4; f32x4 t[8];
#pragma unroll
        for (int i = 0; i < 8; ++i) t[i] = *(const f32x4*)(W + (size_t)(k0 + 8 * i + ks) * N + n0 + n4);
#pragma unroll
        for (int i = 0; i < 8; ++i) { LAS float* d = scr + (8 * i + ks) * 33 + n4; d[0] = t[i].x; d[1] = t[i].y; d[2] = t[i].z; d[3] = t[i].w; }
    }
    LDS_WAIT(); asm volatile("" ::: "memory");
    const int c = lane & 7;
#pragma unroll
    for (int j = 0; j < 4; ++j) { const int n = (lane >> 3) + 8 * j; const LAS float* s = scr + (8 * c) * 33 + n;
        v4u o; o.x = cvtpk(s[0 * 33], s[1 * 33]); o.y = cvtpk(s[2 * 33], s[3 * 33]); o.z = cvtpk(s[4 * 33], s[5 * 33]); o.w = cvtpk(s[6 * 33], s[7 * 33]);
        const int nn = n0 + n; const int row = (mode == 0) ? nn : (32 * (nn >> 4) + (nn & 15) + (mode == 2 ? 16 : 0));
        *(v4u*)(WT + (size_t)row * K + k0 + 8 * c) = o; }
    LDS_WAIT(); asm volatile("" ::: "memory");
}
constexpr int IT_IN = 16 * 96, IT_OUT = 16 * 32, IT_G = 16 * 88, IT_D = 44 * 32, IT_LAYER = IT_IN + IT_OUT + 2 * IT_G + IT_D;
DI void weights_phase(const Params& p, LAS unsigned char* lds, int gw, int NGW, int wave, int lane) {
    LAS float* scr = (LAS float*)(lds + wave * 16384);
    for (int it = gw; it < DEPTH * IT_LAYER; it += NGW) {
        const int l = it / IT_LAYER; int r = it - l * IT_LAYER; const int kind = l % 3, j = l / 3;
        bf16* wl = (bf16*)(p.ws + WS_W + (size_t)l * W_LAYER);
        if (r < IT_IN) {
            const int nN = (kind == 2) ? 1280 : 3072; const int kb = r / 96, nb = r % 96; if (nb * 32 >= nN) continue;
            const float* W = (kind == 0) ? p.sb_in + (size_t)j * DM * 3072 : (kind == 1 ? p.moba_in : p.swa_in);
            transpose_item(W, DM, nN, wl + W_IN / 2, 0, scr, kb, nb, lane); continue; }
        r -= IT_IN;
        if (r < IT_OUT) { const float* W = (kind == 0) ? p.sb_out + (size_t)j * DM * DM : (kind == 1 ? p.moba_out : p.swa_out);
            transpose_item(W, DM, DM, wl + W_OUT / 2, 0, scr, r / 32, r % 32, lane); continue; }
        r -= IT_OUT;
        if (r < IT_G) { transpose_item(p.ffn_g + (size_t)l * DM * FF, DM, FF, wl + W_GU / 2, 1, scr, r / 88, r % 88, lane); continue; }
        r -= IT_G;
        if (r < IT_G) { transpose_item(p.ffn_u + (size_t)l * DM * FF, DM, FF, wl + W_GU / 2, 2, scr, r / 88, r % 88, lane); continue; }
        r -= IT_G;
        transpose_item(p.ffn_d + (size_t)l * FF * DM, FF, DM, wl + W_DN / 2, 0, scr, r / 32, r % 32, lane);
    }
}
DI void mod_phase(const Params& p, LAS unsigned char* lds, int tid, int wave, int lane, int G) {
    if ((int)blockIdx.x >= 192) return;
    float* mod = (float*)(p.ws + WS_MOD);
    LAS float* cact = (LAS float*)lds;
    LAS float* red = (LAS float*)(lds + 32768);
    for (int i = tid; i < NB * DM; i += NTHREADS) { const float v = p.c[i]; cact[i] = v / (1.f + __expf(-v)); }
    __syncthreads();
    for (int item = blockIdx.x; item < 192; item += G) {
        const int l = item / 48, n0 = (item % 48) * 128;
        const float* wp = p.ada_w + ((size_t)l * DM + wave * 128) * 6144 + n0 + 2 * lane;
        float a0[8], a1[8];
#pragma unroll
        for (int b = 0; b < 8; ++b) { a0[b] = 0.f; a1[b] = 0.f; }
#pragma unroll 16
        for (int kk = 0; kk < 128; ++kk) { const f32x2_t w = *(const f32x2_t*)(wp + (size_t)kk * 6144); const int k = wave * 128 + kk;
#pragma unroll
            for (int b = 0; b < 8; ++b) { const float cv = cact[b * DM + k]; a0[b] += cv * w.x; a1[b] += cv * w.y; } }
#pragma unroll
        for (int b = 0; b < 8; ++b) { red[(wave * 8 + b) * 128 + 2 * lane] = a0[b]; red[(wave * 8 + b) * 128 + 2 * lane + 1] = a1[b]; }
        __syncthreads();
#pragma unroll
        for (int r = 0; r < 2; ++r) { const int idx = tid + NTHREADS * r, b = idx >> 7, col = idx & 127; float s = p.ada_b[l * 6144 + n0 + col];
#pragma unroll
            for (int w = 0; w < 8; ++w) s += red[(w * 8 + b) * 128 + col];
            mod[(size_t)(l * 8 + b) * 6144 + n0 + col] = s; }
        __syncthreads();
    }
}
DI void xs0_phase(const float* xs, const float* gain, const float* mod_l, bf16* h, unsigned long long* rowsq, int NGW, const int wave_s) {
    PHASE_IDS();
    for (int m0 = gw; m0 < MTOK; m0 += 4 * NGW) {
        f32x4 v[4][4];
#pragma unroll
        for (int r = 0; r < 4; ++r) { const int m = m0 + r * NGW; const f32x4* xr = (const f32x4*)(xs + (size_t)((m < MTOK) ? m : m0) * DM) + lane;
#pragma unroll
            for (int j = 0; j < 4; ++j) v[r][j] = xr[64 * j]; }
#pragma unroll
        for (int r = 0; r < 4; ++r) { const int m = m0 + r * NGW; if (m >= MTOK) break;
            const int b = m >> 12; float ss = 0.f;
#pragma unroll
            for (int j = 0; j < 4; ++j) ss += (v[r][j].x * v[r][j].x + v[r][j].y * v[r][j].y) + (v[r][j].z * v[r][j].z + v[r][j].w * v[r][j].w);
            ss = wave_sum(ss, x32);
            if (lane == 0) rowsq[m] = (unsigned long long)(ss * 4294967296.f);
            unsigned long long* o8 = (unsigned long long*)(h + (size_t)m * DM) + lane;
#pragma unroll
            for (int j = 0; j < 4; ++j) { const int col = 4 * lane + 256 * j;
                const f32x4 g = *(const f32x4*)(gain + col), sc = *(const f32x4*)(mod_l + (size_t)b * 6144 + DM + col);
                const f32x4 y = v[r][j] * (g * (sc + 1.f));
                o8[64 * j] = (unsigned long long)cvtpk(y.x, y.y) | ((unsigned long long)cvtpk(y.z, y.w) << 32); } }
    }
}
DI void bias_phase(const unsigned char* wsb, int NGW, const int wave_s) {
    PHASE_IDS();
    const float* mod = (const float*)(wsb + WS_MOD);
    constexpr int RPL = 3072 + 5632, RTOT = DEPTH * RPL;
    const int chunk = (RTOT + NGW - 1) / NGW;
    const int it0 = gw * chunk, it1 = (it0 + chunk < RTOT) ? it0 + chunk : RTOT;
    int cur = -1;
    f32x4 sh[8][4];
#pragma unroll
    for (int b = 0; b < 8; ++b)
#pragma unroll
        for (int q = 0; q < 4; ++q) sh[b][q] = (f32x4){0.f, 0.f, 0.f, 0.f};
    for (int itb = it0; itb < it1; itb += 4) {
        v4u w0[4], w1[4];
#pragma unroll
        for (int u = 0; u < 4; ++u) { const int it = (itb + u < it1) ? itb + u : it1 - 1; const int l = it / RPL, r = it - l * RPL; const bool first = r < 3072; const int rr = first ? r : r - 3072;
            const bf16* wrow = (const bf16*)(wsb + WS_W + (size_t)l * W_LAYER + (first ? W_IN : W_GU)) + (size_t)rr * DM;
            w0[u] = *(const v4u*)(wrow + 8 * lane); w1[u] = *(const v4u*)(wrow + 512 + 8 * lane); }
#pragma unroll
        for (int u = 0; u < 4; ++u) {
            const int it = itb + u; if (it >= it1) break;
            const int l = it / RPL, r = it - l * RPL, kind = l % 3; const bool first = r < 3072; const int rr = first ? r : r - 3072;
            if (first && kind == 2 && rr >= 1280) continue;
            const int key = l * 2 + (first ? 0 : 1);
            if (key != cur) { cur = key;
#pragma unroll
                for (int b = 0; b < 8; ++b) { const float* sp = mod + (size_t)(l * 8 + b) * 6144 + (first ? 0 : 3 * DM) + 8 * lane;
                    sh[b][0] = *(const f32x4*)sp; sh[b][1] = *(const f32x4*)(sp + 4); sh[b][2] = *(const f32x4*)(sp + 512); sh[b][3] = *(const f32x4*)(sp + 516); } }
            float wf[16];
#pragma unroll
            for (int t = 0; t < 4; ++t) { wf[2 * t] = __builtin_bit_cast(float, w0[u][t] << 16); wf[2 * t + 1] = __builtin_bit_cast(float, w0[u][t] & 0xffff0000u);
                wf[8 + 2 * t] = __builtin_bit_cast(float, w1[u][t] << 16); wf[8 + 2 * t + 1] = __builtin_bit_cast(float, w1[u][t] & 0xffff0000u); }
            float* bout = (float*)(wsb + WS_BIAS + (size_t)l * BIAS_LAYER) + (first ? 0 : 8 * 3072);
            const int ld = first ? 3072 : 5632;
            float res = 0.f;
#pragma unroll
            for (int b = 0; b < 8; ++b) { float d = 0.f;
#pragma unroll
                for (int e = 0; e < 4; ++e) d += sh[b][0][e] * wf[e] + sh[b][1][e] * wf[4 + e] + sh[b][2][e] * wf[8 + e] + sh[b][3][e] * wf[12 + e];
                d = wave_sum(d, x32);
                if (lane == b) res = d; }
            if (lane < 8) bout[(size_t)lane * ld + rr] = res;
        }
    }
}
DI void rope_phase(bf16* qb, unsigned char* kfb, int nkv, const float* gains, bool do_kmean, bf16* kmean, int NGW, const int wave_s) {
    const int nslots = nkv;
    PHASE_IDS();
    const int sub = lane >> 3, j = lane & 7;
    float invf[8];
#pragma unroll
    for (int t = 0; t < 8; ++t) invf[t] = exp2f(-(float)(8 * (j & 3) + t) * (13.287712379549449f / 32.f));
    for (int id = gw; id < NB * 16 * nslots; id += NGW) {
        const int slot = 16 + id % nslots, bn = id / nslots, b = bn >> 4, n = bn & 15;
        float g[8];
#pragma unroll
        for (int t = 0; t < 8; ++t) g[t] = gains[(slot < 16 ? 0 : 64) + 8 * j + t];
        float ksum[8];
#pragma unroll
        for (int t = 0; t < 8; ++t) ksum[t] = 0.f;
        for (int itb = 0; itb < 32; itb += 8) {
            v4u rawv[8]; bf16* ptrv[8];
#pragma unroll
            for (int u = 0; u < 8; ++u) { const int tok = n * 256 + (itb + u) * 8 + sub;
                ptrv[u] = (slot < 16) ? qb + (size_t)(b * SEQ + tok) * 1024 + slot * 64 + 8 * j
                                      : (bf16*)(kfb + ((size_t)((b * nkv + (slot - 16)) * 128 + (tok >> 5)) << 12) + (j >> 1) * 1024 + ((j & 1) * 32 + pg8::pi32(tok & 31)) * 16);
                rawv[u] = *(const v4u*)ptrv[u]; }
#pragma unroll
            for (int u = 0; u < 8; ++u) {
            const int tok = n * 256 + (itb + u) * 8 + sub;
            bf16* ptr = ptrv[u];
            const v4u raw = rawv[u];
            float v[8];
#pragma unroll
            for (int t = 0; t < 4; ++t) { v[2 * t] = __builtin_bit_cast(float, raw[t] << 16); v[2 * t + 1] = __builtin_bit_cast(float, raw[t] & 0xffff0000u); }
            float ss = 0.f;
#pragma unroll
            for (int t = 0; t < 8; ++t) ss += v[t] * v[t];
            ss += swz_xor<1>(ss); ss += swz_xor<2>(ss); ss += swz_xor<4>(ss);
            const float rstd = rsqrtf(ss * (1.f / 64.f) + EPS);
            float o[8];
#pragma unroll
            for (int t = 0; t < 8; ++t) {
                const float vv = v[t] * rstd * g[t];
                const float pv = swz_xor<4>(vv);
                float r = (float)tok * invf[t] * 0.15915494309189535f; r = r - floorf(r);
                const float cs = __builtin_amdgcn_cosf(r), sn = __builtin_amdgcn_sinf(r);
                o[t] = (j < 4) ? (vv * cs - pv * sn) : (vv * cs + pv * sn);
                ksum[t] += o[t];
            }
            v4u w; w.x = cvtpk(o[0], o[1]); w.y = cvtpk(o[2], o[3]); w.z = cvtpk(o[4], o[5]); w.w = cvtpk(o[6], o[7]);
            *(v4u*)ptr = w;
            }
        }
        if (do_kmean && slot >= 16) {
#pragma unroll
            for (int t = 0; t < 8; ++t) { float s = ksum[t]; s += swz_xor<8>(s); s += swz_xor<16>(s); s += bperm(s, x32); ksum[t] = s * (1.f / 256.f); }
            if (sub == 0) { v4u w; w.x = cvtpk(ksum[0], ksum[1]); w.y = cvtpk(ksum[2], ksum[3]); w.z = cvtpk(ksum[4], ksum[5]); w.w = cvtpk(ksum[6], ksum[7]);
                *(v4u*)(kmean + (size_t)((b * 16 + (slot - 16)) * 16 + n) * 64 + 8 * j) = w; }
        }
    }
}
DI f32x16 zero16() { f32x16 z;
#pragma unroll
    for (int i = 0; i < 16; ++i) z[i] = 0.f;
    return z; }
DI void pv_regs(const bf16x8 (&vf)[4], const f32x16& p, f32x16& O0, f32x16& O1) {
    v4u pk; pk.x = cvtpk(p[0], p[1]); pk.y = cvtpk(p[2], p[3]); pk.z = cvtpk(p[4], p[5]); pk.w = cvtpk(p[6], p[7]);
    const bf16x8 pb0 = __builtin_bit_cast(bf16x8, pk);
    pk.x = cvtpk(p[8], p[9]); pk.y = cvtpk(p[10], p[11]); pk.z = cvtpk(p[12], p[13]); pk.w = cvtpk(p[14], p[15]);
    const bf16x8 pb1 = __builtin_bit_cast(bf16x8, pk);
    O0 = MFMA32(vf[0], pb0, O0); O1 = MFMA32(vf[2], pb0, O1);
    O0 = MFMA32(vf[1], pb1, O0); O1 = MFMA32(vf[3], pb1, O1);
}
DI void softmax_update(f32x16& s, float& m_run, float& l_run, f32x16& O0, f32x16& O1, int x32) {
    float tmax = s[0];
#pragma unroll
    for (int i = 1; i < 16; ++i) tmax = fmaxf(tmax, s[i]);
    tmax = fmaxf(tmax, bperm(tmax, x32));
    const float m_new = fmaxf(m_run, tmax);
    const float m_use = (m_new == -INFINITY) ? 0.f : m_new;
    const float alpha = __builtin_amdgcn_exp2f(m_run - m_use);
    float rs = 0.f;
#pragma unroll
    for (int i = 0; i < 16; ++i) { s[i] = __builtin_amdgcn_exp2f(s[i] - m_use); rs += s[i]; }
    rs += bperm(rs, x32);
    l_run = l_run * alpha + rs; m_run = m_new;
    O0 = O0 * alpha; O1 = O1 * alpha;
}
template <int MODE>
DI bool attn_tile(const bf16x8 (&kf)[4], const bf16x8 (&vf)[4], const bf16x8 (&qf)[4], int key0, int q0, int tq, int hi, int x32, int own, unsigned selmask,
                  float& m_run, float& l_run, f32x16& O0, f32x16& O1) {
    f32x16 s = zero16();
#pragma unroll
    for (int kk = 0; kk < 4; ++kk) s = MFMA32(kf[kk], qf[kk], s);
    if constexpr (MODE == 0) {
        float lk[16];
        if (key0 == q0) {
#pragma unroll
            for (int i = 0; i < 16; ++i) {
                const int key = key0 + 16 * (i >> 3) + 8 * hi + (i & 7);
                const bool past = key < tq;
                const float z = s[i] * SC2;
                const float l1 = __builtin_amdgcn_logf(1.f + __builtin_amdgcn_exp2f(-fabsf(z)));
                s[i] = past ? (fminf(z, 0.f) - l1) : -INFINITY;
                lk[i] = past ? -(fmaxf(z, 0.f) + l1) : 0.f;
            }
        } else {
#pragma unroll
            for (int i = 0; i < 16; ++i) {
                const float z = s[i] * SC2;
                const float l1 = __builtin_amdgcn_logf(1.f + __builtin_amdgcn_exp2f(-fabsf(z)));
                s[i] = fminf(z, 0.f) - l1; lk[i] = -(fmaxf(z, 0.f) + l1);
            }
        }
        float s_lo = 0.f, s_hi = 0.f;
#pragma unroll
        for (int i = 0; i < 8; ++i) { s_lo += lk[i]; s_hi += lk[8 + i]; }
        const float p_lo = bperm(s_lo, x32), p_hi = bperm(s_hi, x32);
        const float carry = m_run;
        float off_hi = hi ? carry : carry + p_hi;
        float off_lo = hi ? carry + s_hi + p_hi : carry + p_hi + s_hi + p_lo;
#pragma unroll
        for (int i = 7; i >= 0; --i) { s[8 + i] = __builtin_amdgcn_exp2f(s[8 + i] + off_hi); off_hi += lk[8 + i]; s[i] = __builtin_amdgcn_exp2f(s[i] + off_lo); off_lo += lk[i]; }
        m_run = carry + ((s_lo + s_hi) + (p_lo + p_hi));
        pv_regs(vf, s, O0, O1);
        return __all(m_run < -36.f);
    } else if constexpr (MODE == 2) {
        if (key0 == q0 || key0 + 128 == q0) {
#pragma unroll
            for (int i = 0; i < 16; ++i) { const int key = key0 + 16 * (i >> 3) + 8 * hi + (i & 7);
                s[i] = (key <= tq && key > tq - 128) ? s[i] * SC2 : -INFINITY; }
        } else {
#pragma unroll
            for (int i = 0; i < 16; ++i) s[i] = s[i] * SC2;
        }
        softmax_update(s, m_run, l_run, O0, O1, x32);
        pv_regs(vf, s, O0, O1);
        return false;
    } else {
        const int blk = key0 >> 8; const float B2 = m_run;
        if (key0 == q0) {
#pragma unroll
            for (int i = 0; i < 16; ++i) { const int key = key0 + 16 * (i >> 3) + 8 * hi + (i & 7); const float p = __builtin_amdgcn_exp2f((key <= tq) ? s[i] * SC2 - B2 : -INFINITY); s[i] = p; l_run += p; }
        } else {
            const float bsh = (blk == own || ((selmask >> blk) & 1u)) ? B2 : INFINITY;
#pragma unroll
            for (int i = 0; i < 8; ++i) { const float p = __builtin_amdgcn_exp2f(s[i] * SC2 - bsh); s[i] = p; l_run += p; }
            { v4u pk; pk.x = cvtpk(s[0], s[1]); pk.y = cvtpk(s[2], s[3]); pk.z = cvtpk(s[4], s[5]); pk.w = cvtpk(s[6], s[7]);
              const bf16x8 pb0 = __builtin_bit_cast(bf16x8, pk); O0 = MFMA32(vf[0], pb0, O0); O1 = MFMA32(vf[2], pb0, O1); }
#pragma unroll
            for (int i = 8; i < 16; ++i) { const float p = __builtin_amdgcn_exp2f(s[i] * SC2 - bsh); s[i] = p; l_run += p; }
            { v4u pk; pk.x = cvtpk(s[8], s[9]); pk.y = cvtpk(s[10], s[11]); pk.z = cvtpk(s[12], s[13]); pk.w = cvtpk(s[14], s[15]);
              const bf16x8 pb1 = __builtin_bit_cast(bf16x8, pk); O0 = MFMA32(vf[1], pb1, O0); O1 = MFMA32(vf[3], pb1, O1); }
            return false;
        }
        pv_regs(vf, s, O0, O1);
        return false;
    }
}
DI void rope_q(bf16x8 (&qf)[4], const float* gq, int pos, int hi, int x32) {
    float v[4][8]; float ss = 0.f;
#pragma unroll
    for (int kk = 0; kk < 4; ++kk) { const v4u raw = __builtin_bit_cast(v4u, qf[kk]);
#pragma unroll
        for (int t = 0; t < 4; ++t) { v[kk][2 * t] = __builtin_bit_cast(float, raw[t] << 16); v[kk][2 * t + 1] = __builtin_bit_cast(float, raw[t] & 0xffff0000u); } }
#pragma unroll
    for (int kk = 0; kk < 4; ++kk)
#pragma unroll
        for (int j = 0; j < 8; ++j) ss += v[kk][j] * v[kk][j];
    ss += bperm(ss, x32);
    const float rstd = rsqrtf(ss * (1.f / 64.f) + EPS);
#pragma unroll
    for (int kk = 0; kk < 4; ++kk) { const f32x4 g0 = *(const f32x4*)(gq + 16 * kk + 8 * hi), g1 = *(const f32x4*)(gq + 16 * kk + 8 * hi + 4);
#pragma unroll
        for (int j = 0; j < 4; ++j) { v[kk][j] = v[kk][j] * rstd * g0[j]; v[kk][4 + j] = v[kk][4 + j] * rstd * g1[j]; } }
#pragma unroll
    for (int kk = 0; kk < 2; ++kk)
#pragma unroll
        for (int j = 0; j < 8; ++j) {
            const float invf = exp2f(-(float)(16 * kk + 8 * hi + j) * (13.287712379549449f / 32.f));
            float r = (float)pos * invf * 0.15915494309189535f; r = r - floorf(r);
            const float cs = __builtin_amdgcn_cosf(r), sn = __builtin_amdgcn_sinf(r);
            const float x1 = v[kk][j], x2 = v[kk + 2][j];
            v[kk][j] = x1 * cs - x2 * sn; v[kk + 2][j] = x2 * cs + x1 * sn; }
#pragma unroll
    for (int kk = 0; kk < 4; ++kk) { v4u w; w.x = cvtpk(v[kk][0], v[kk][1]); w.y = cvtpk(v[kk][2], v[kk][3]); w.z = cvtpk(v[kk][4], v[kk][5]); w.w = cvtpk(v[kk][6], v[kk][7]); qf[kk] = __builtin_bit_cast(bf16x8, w); }
}
DI unsigned moba_select(const bf16x8 (&qf)[4], const bf16* kmean, int b, int h, int own, int hi, int col, int x32) {
    unsigned selmask = 0u;
    const char* kmb = (const char*)(kmean + (size_t)((b * 16 + h) * 16) * 64);
    const unsigned kmo = (unsigned)((col & 15) * 64 + 8 * hi) * 2u;
    f32x16 g = zero16();
#pragma unroll
    for (int kk = 0; kk < 4; ++kk) { const bf16x8 kf = *(const bf16x8*)(kmb + kmo + 32 * kk); g = MFMA32(kf, qf[kk], g); }
    float val[8];
    const int own4 = own - 4 * hi;
#pragma unroll
    for (int i = 0; i < 8; ++i) val[i] = ((i & 3) + 8 * (i >> 2) < own4) ? g[i] : -INFINITY;
    float lv[3]; int ln[3];
#pragma unroll
    for (int r = 0; r < 3; ++r) { float best = -INFINITY; int bi = 8;
#pragma unroll
        for (int i = 0; i < 8; ++i) if (val[i] > best) { best = val[i]; bi = i; }
#pragma unroll
        for (int i = 0; i < 8; ++i) if (bi == i) val[i] = -INFINITY;
        lv[r] = best; ln[r] = (bi < 8) ? ((bi & 3) + 8 * (bi >> 2) + 4 * hi) : 99; }
    float cv[6]; int cn[6];
#pragma unroll
    for (int r = 0; r < 3; ++r) { const float pv = bperm(lv[r], x32); const int pn = bperm_i(ln[r], x32);
        cv[r] = hi ? pv : lv[r]; cn[r] = hi ? pn : ln[r]; cv[3 + r] = hi ? lv[r] : pv; cn[3 + r] = hi ? ln[r] : pn; }
#pragma unroll
    for (int r = 0; r < 3; ++r) { float best = -INFINITY; int bi = 6;
#pragma unroll
        for (int i = 0; i < 6; ++i) if (cv[i] > best) { best = cv[i]; bi = i; }
        int bn = 99;
#pragma unroll
        for (int i = 0; i < 6; ++i) if (bi == i) { cv[i] = -INFINITY; bn = cn[i]; }
        if (bn < 16) selmask |= 1u << bn; }
    return selmask;
}
DI void moba_wg_phase(const bf16* qb, const unsigned char* kfb, const unsigned char* vfb, bf16* ob, const bf16* kmean, const float* gains, int G, LAS unsigned char* lds, const int wave_s) {
    PHASE_IDS();
    float B2;
    { float a = fabsf(gains[lane]), c = fabsf(gains[64 + lane]);
      a = fmaxf(a, swz_xor<1>(a)); a = fmaxf(a, swz_xor<2>(a)); a = fmaxf(a, swz_xor<4>(a)); a = fmaxf(a, swz_xor<8>(a)); a = fmaxf(a, swz_xor<16>(a)); a = fmaxf(a, bperm(a, x32));
      c = fmaxf(c, swz_xor<1>(c)); c = fmaxf(c, swz_xor<2>(c)); c = fmaxf(c, swz_xor<4>(c)); c = fmaxf(c, swz_xor<8>(c)); c = fmaxf(c, swz_xor<16>(c)); c = fmaxf(c, bperm(c, x32));
      B2 = 1.02f * 8.f * 1.4426950408889634f * a * c; }
    const int nx = (G % 8 == 0) ? 8 : 1, per = G / nx, upx = 2048 / nx;
    const int xx = (nx == 8) ? ((int)blockIdx.x & 7) : 0, gi = (nx == 8) ? ((int)blockIdx.x >> 3) : (int)blockIdx.x;
    const unsigned wpiece = (unsigned)(wave >> 2) * 4096u + (unsigned)(wave & 3) * 1024u;
    for (int v = gi; v < upx; v += per) {
        int lane_u = lane; asm volatile("" : "+v"(lane_u));
        const int hi = lane_u >> 5, col = lane_u & 31, xq = (lane_u ^ 32) << 2; const unsigned lofs = (unsigned)lane_u * 16u;
        const int it = v / per, own = (v + it) & 15, bh = xx * (128 / nx) + (v >> 4), b = bh >> 4, h = bh & 15;
        const int tok0 = b * SEQ, q0 = own * 256 + 32 * wave, tq = q0 + col;
        const char* gsrc = (const char*)((wave < 4) ? kfb : vfb) + ((size_t)((b * 16 + h) * 128) << 12) + (unsigned)(wave & 3) * 1024u + lofs;
        const int nt = 8 * own + 8;
#define MW_DMA_BLK(blkidx, buf) do { _Pragma("unroll") for (int z_ = 0; z_ < 8; ++z_) \
            __builtin_amdgcn_global_load_lds((const unsigned*)(gsrc + (size_t)((blkidx) * 8 + z_) * 4096), (LAS unsigned*)(lds + (unsigned)(buf) * 65536u + (unsigned)z_ * 8192u + wpiece), 16, 0, 0); } while (0)
        MW_DMA_BLK(0, 0);
        bf16x8 qf[4];
        { const bf16* qp = qb + (size_t)(tok0 + tq) * 1024 + h * 64 + 8 * hi;
#pragma unroll
          for (int kk = 0; kk < 4; ++kk) qf[kk] = *(const bf16x8*)(qp + 16 * kk); }
        rope_q(qf, gains, tq, hi, xq);
        const unsigned selmask = moba_select(qf, kmean, b, h, own, hi, col, xq);
        unsigned anym = 0u;
        for (int n = 0; n < own; ++n) if (__any((selmask >> n) & 1u)) anym |= 1u << n;
        anym = __builtin_amdgcn_readfirstlane(anym);
        f32x16 O0 = zero16(), O1 = zero16(); float m_run = B2, l_run = 0.f;
        for (int n = 0; n <= own; ++n) {
            asm volatile("s_waitcnt vmcnt(0)" ::: "memory");
            __builtin_amdgcn_s_barrier();
            if (n < own) MW_DMA_BLK(n + 1, (n + 1) & 1);
            const bool need = (n < own) ? (((anym >> n) & 1u) != 0u) : true;
            if (need) { const int ntile = (n < own) ? 8 : (wave + 1);
                for (int t = 0; t < ntile; ++t) {
                    const LAS unsigned char* sl = lds + (unsigned)(n & 1) * 65536u + (unsigned)t * 8192u + lofs; bf16x8 kf[4], vf[4];
                    kf[0] = *(const LAS bf16x8*)(sl); kf[1] = *(const LAS bf16x8*)(sl + 1024); kf[2] = *(const LAS bf16x8*)(sl + 2048); kf[3] = *(const LAS bf16x8*)(sl + 3072);
                    vf[0] = *(const LAS bf16x8*)(sl + 4096); vf[1] = *(const LAS bf16x8*)(sl + 5120); vf[2] = *(const LAS bf16x8*)(sl + 6144); vf[3] = *(const LAS bf16x8*)(sl + 7168);
                    (void)attn_tile<1>(kf, vf, qf, n * 256 + 32 * t, q0, tq, hi, xq, own, selmask, m_run, l_run, O0, O1); } }
        }
#undef MW_DMA_BLK
        l_run += bperm(l_run, xq);
        const float inv_l = 1.f / l_run;
        bf16* op = ob + (size_t)(tok0 + tq) * DM + h * 64 + 4 * hi;
#pragma unroll
        for (int g = 0; g < 4; ++g) { uint2 w0, w1;
            w0.x = cvtpk(O0[4 * g] * inv_l, O0[4 * g + 1] * inv_l); w0.y = cvtpk(O0[4 * g + 2] * inv_l, O0[4 * g + 3] * inv_l);
            w1.x = cvtpk(O1[4 * g] * inv_l, O1[4 * g + 1] * inv_l); w1.y = cvtpk(O1[4 * g + 2] * inv_l, O1[4 * g + 3] * inv_l);
            *(uint2*)(op + 8 * g) = w0; *(uint2*)(op + 32 + 8 * g) = w1; }
        __builtin_amdgcn_s_barrier();
    }
}
DI void swa_tile_sf(const bf16x8 (&kf)[4], const bf16x8 (&vf)[4], const bf16x8 (&qf)[4], int key0, int q0, int tq, int hi, float B2, float& l_run, f32x16& O0, f32x16& O1) {
    f32x16 s = zero16();
#pragma unroll
    for (int kk = 0; kk < 4; ++kk) s = MFMA32(kf[kk], qf[kk], s);
    if (key0 == q0 || key0 + 128 == q0) {
#pragma unroll
        for (int i = 0; i < 16; ++i) { const int key = key0 + 16 * (i >> 3) + 8 * hi + (i & 7);
            const float p = __builtin_amdgcn_exp2f((key <= tq && key > tq - 128) ? s[i] * SC2 - B2 : -INFINITY); s[i] = p; l_run += p; }
    } else {
#pragma unroll
        for (int i = 0; i < 16; ++i) { const float p = __builtin_amdgcn_exp2f(s[i] * SC2 - B2); s[i] = p; l_run += p; }
    }
    pv_regs(vf, s, O0, O1);
}
DI void swa_wg_phase(const bf16* qb, const unsigned char* kfb, const unsigned char* vfb, bf16* ob, const float* sinks, const float* gains, int G, LAS unsigned char* lds, const int wave_s) {
    PHASE_IDS();
    float B2;
    { float a = fabsf(gains[lane]), c = fabsf(gains[64 + lane]);
      a = fmaxf(a, swz_xor<1>(a)); a = fmaxf(a, swz_xor<2>(a)); a = fmaxf(a, swz_xor<4>(a)); a = fmaxf(a, swz_xor<8>(a)); a = fmaxf(a, swz_xor<16>(a)); a = fmaxf(a, bperm(a, x32));
      c = fmaxf(c, swz_xor<1>(c)); c = fmaxf(c, swz_xor<2>(c)); c = fmaxf(c, swz_xor<4>(c)); c = fmaxf(c, swz_xor<8>(c)); c = fmaxf(c, swz_xor<16>(c)); c = fmaxf(c, bperm(c, x32));
      B2 = 1.02f * 8.f * 1.4426950408889634f * a * c; }
    const unsigned wpiece = (unsigned)(wave >> 2) * 4096u + (unsigned)(wave & 3) * 1024u;
    for (int sidx = (int)blockIdx.x; sidx < 256; sidx += G) {
        int lane_u = lane; asm volatile("" : "+v"(lane_u));
        const int hi = lane_u >> 5, col = lane_u & 31, xq = (lane_u ^ 32) << 2; const unsigned lofs = (unsigned)lane_u * 16u;
        const int pair = sidx >> 4, b = pair >> 1, kvh = pair & 1, qcs = (sidx & 15) * 8, h = kvh * 8 + wave, tok0 = b * SEQ;
        const char* gsrc = (const char*)((wave < 4) ? kfb : vfb) + ((size_t)((b * 2 + kvh) * 128) << 12) + (unsigned)(wave & 3) * 1024u + lofs;
#define SW_DMA(tile) __builtin_amdgcn_global_load_lds((const unsigned*)(gsrc + (size_t)(tile) * 4096), (LAS unsigned*)(lds + (unsigned)((tile) & 7) * 8192u + wpiece), 16, 0, 0)
        const int tlo = (qcs >= 4) ? qcs - 4 : 0;
        for (int t = tlo; t <= qcs; ++t) SW_DMA(t);
        const float sink2 = sinks[h] * 1.4426950408889634f;
        const bf16* qrow = qb + (size_t)(tok0 + qcs * 32 + col) * 1024 + h * 64 + 8 * hi;
        bf16x8 qf[4];
#pragma unroll
        for (int kk = 0; kk < 4; ++kk) qf[kk] = *(const bf16x8*)(qrow + 16 * kk);
        for (int u = 0; u < 8; ++u) {
            const int qc = qcs + u, q0 = qc * 32, tq = q0 + col;
            asm volatile("s_waitcnt vmcnt(0)" ::: "memory");
            __builtin_amdgcn_s_barrier();
            if (u < 7) SW_DMA(qc + 1);
            bf16x8 qn[4];
#pragma unroll
            for (int kk = 0; kk < 4; ++kk) qn[kk] = *(const bf16x8*)(qrow + (size_t)((u < 7) ? 32 * (u + 1) : 32 * u) * 1024 + 16 * kk);
            rope_q(qf, gains, tq, hi, xq);
            f32x16 O0 = zero16(), O1 = zero16(); float l_run = 0.f;
            for (int t = (qc >= 4) ? qc - 4 : 0; t <= qc; ++t) {
                const LAS unsigned char* sl = lds + (unsigned)(t & 7) * 8192u + lofs; bf16x8 kf[4], vf[4];
                kf[0] = *(const LAS bf16x8*)(sl); kf[1] = *(const LAS bf16x8*)(sl + 1024); kf[2] = *(const LAS bf16x8*)(sl + 2048); kf[3] = *(const LAS bf16x8*)(sl + 3072);
                vf[0] = *(const LAS bf16x8*)(sl + 4096); vf[1] = *(const LAS bf16x8*)(sl + 5120); vf[2] = *(const LAS bf16x8*)(sl + 6144); vf[3] = *(const LAS bf16x8*)(sl + 7168);
                swa_tile_sf(kf, vf, qf, 32 * t, q0, tq, hi, B2, l_run, O0, O1); }
            l_run += bperm(l_run, xq);
            const float inv_l = 1.f / (l_run + __builtin_amdgcn_exp2f(sink2 - B2));
            bf16* op = ob + (size_t)(tok0 + tq) * DM + h * 64 + 4 * hi;
#pragma unroll
            for (int g = 0; g < 4; ++g) { uint2 w0, w1;
                w0.x = cvtpk(O0[4 * g] * inv_l, O0[4 * g + 1] * inv_l); w0.y = cvtpk(O0[4 * g + 2] * inv_l, O0[4 * g + 3] * inv_l);
                w1.x = cvtpk(O1[4 * g] * inv_l, O1[4 * g + 1] * inv_l); w1.y = cvtpk(O1[4 * g + 2] * inv_l, O1[4 * g + 3] * inv_l);
                *(uint2*)(op + 8 * g) = w0; *(uint2*)(op + 32 + 8 * g) = w1; }
#pragma unroll
            for (int kk = 0; kk < 4; ++kk) qf[kk] = qn[kk];
        }
#undef SW_DMA
        asm volatile("s_waitcnt vmcnt(0)" ::: "memory");
        __builtin_amdgcn_s_barrier();
    }
}
DI void sb_wg_phase(const bf16* qb, const unsigned char* kfb, const unsigned char* vfb, bf16* ob, int G, LAS unsigned char* lds, const int wave_s) {
    PHASE_IDS();
    const unsigned wpiece = (unsigned)(wave >> 2) * 4096u + (unsigned)(wave & 3) * 1024u;
    const int nx = (G % 8 == 0) ? 8 : 1, per = G / nx, upx = 2048 / nx;
    const int xx = (nx == 8) ? ((int)blockIdx.x & 7) : 0, gi = (nx == 8) ? ((int)blockIdx.x >> 3) : (int)blockIdx.x;
    for (int v = gi; v < upx; v += per) {
        int lane_u = lane; asm volatile("" : "+v"(lane_u));
        const int hi = lane_u >> 5, col = lane_u & 31, xq = (lane_u ^ 32) << 2; const unsigned lofs = (unsigned)lane_u * 16u;
        const int bh = xx * (128 / nx) + (v >> 4), b = bh >> 4, h = bh & 15, qc0 = (v & 15) * 8, qc = qc0 + wave, q0 = 32 * qc, tq = q0 + col, tok0 = b * SEQ;
        const size_t hbase = (size_t)((b * 16 + h) * 128) << 12;
        const char* gsrc = (const char*)((wave < 4) ? kfb : vfb) + hbase + (unsigned)(wave & 3) * 1024u + lofs;
        const int tlo = (qc0 >= 8) ? qc0 - 8 : 0;
        for (int t = tlo; t < qc0 + 8; ++t)
            __builtin_amdgcn_global_load_lds((const unsigned*)(gsrc + (size_t)t * 4096), (LAS unsigned*)(lds + (unsigned)(t & 15) * 8192u + wpiece), 16, 0, 0);
        bf16x8 qf[4];
        { const bf16* qp = qb + (size_t)(tok0 + tq) * 1024 + h * 64 + 8 * hi;
#pragma unroll
          for (int kk = 0; kk < 4; ++kk) qf[kk] = *(const bf16x8*)(qp + 16 * kk); }
        asm volatile("s_waitcnt vmcnt(0)" ::: "memory");
        __builtin_amdgcn_s_barrier();
        f32x16 O0 = zero16(), O1 = zero16(); float carry = 0.f, lr = 0.f;
        for (int t = qc; t >= 0; --t) {
            bf16x8 kf[4], vf[4];
            if (t >= tlo) { const LAS unsigned char* sl = lds + (unsigned)(t & 15) * 8192u + lofs;
                kf[0] = *(const LAS bf16x8*)(sl); kf[1] = *(const LAS bf16x8*)(sl + 1024); kf[2] = *(const LAS bf16x8*)(sl + 2048); kf[3] = *(const LAS bf16x8*)(sl + 3072);
                vf[0] = *(const LAS bf16x8*)(sl + 4096); vf[1] = *(const LAS bf16x8*)(sl + 5120); vf[2] = *(const LAS bf16x8*)(sl + 6144); vf[3] = *(const LAS bf16x8*)(sl + 7168); }
            else { const char* kb_ = (const char*)kfb + hbase + ((size_t)t << 12) + lofs; const char* vb_ = (const char*)vfb + hbase + ((size_t)t << 12) + lofs;
                kf[0] = *(const bf16x8*)(kb_); kf[1] = *(const bf16x8*)(kb_ + 1024); kf[2] = *(const bf16x8*)(kb_ + 2048); kf[3] = *(const bf16x8*)(kb_ + 3072);
                vf[0] = *(const bf16x8*)(vb_); vf[1] = *(const bf16x8*)(vb_ + 1024); vf[2] = *(const bf16x8*)(vb_ + 2048); vf[3] = *(const bf16x8*)(vb_ + 3072); }
            if (attn_tile<0>(kf, vf, qf, 32 * t, q0, tq, hi, xq, 0, 0u, carry, lr, O0, O1)) break;
        }
        bf16* op = ob + (size_t)(tok0 + tq) * DM + h * 64 + 4 * hi;
#pragma unroll
        for (int g = 0; g < 4; ++g) { uint2 w0, w1;
            w0.x = cvtpk(O0[4 * g], O0[4 * g + 1]); w0.y = cvtpk(O0[4 * g + 2], O0[4 * g + 3]);
            w1.x = cvtpk(O1[4 * g], O1[4 * g + 1]); w1.y = cvtpk(O1[4 * g + 2], O1[4 * g + 3]);
            *(uint2*)(op + 8 * g) = w0; *(uint2*)(op + 32 + 8 * g) = w1; }
        __builtin_amdgcn_s_barrier();
    }
}
__global__ void __launch_bounds__(NTHREADS, 2) trunk_fwd(Params p) {
    extern __shared__ __attribute__((aligned(16))) unsigned char lds_raw[];
    cg::grid_group grid = cg::this_grid();
    LAS unsigned char* lds = (LAS unsigned char*)lds_raw;
    const int tid = threadIdx.x, lane = tid & 63, wave = __builtin_amdgcn_readfirstlane(tid >> 6); const int wave_s = wave;
    const int G = gridDim.x, gw = blockIdx.x * NWAVES + wave, NGW = G * NWAVES;
    unsigned char* ws0 = p.ws;
#define ws (KP()->ws)
#define mod ((float*)(ws + WS_MOD))
#define kmean ((bf16*)(ws + WS_KMEAN))
#define HB ((bf16*)(ws + WS_H))
#define OB ((bf16*)(ws + WS_O))
#define QK ((bf16*)(ws + WS_QK))
#define VT ((bf16*)(ws + WS_VT))
#define ACT ((bf16*)(ws + WS_ACT))

    if (tid < 8) ((volatile LAS unsigned*)(lds + MISC_OFF))[tid] = 0u;
    __syncthreads();
    const XcdBarrier bar = xcd_barrier_post((unsigned*)(ws0 + WS_BAR), (volatile LAS unsigned*)(lds + MISC_OFF));
#define GSYNC() do { int l_; asm volatile("v_mbcnt_lo_u32_b32 %0, -1, 0\n\tv_mbcnt_hi_u32_b32 %0, -1, %0" : "=v"(l_)); xcd_barrier(bar, (wave_s * 64 + l_) == 0); } while (0)
    mod_phase(p, lds, tid, wave, lane, G);
    __syncthreads();
    weights_phase(p, lds, gw, NGW, wave, lane);
    { unsigned long long* rsq = (unsigned long long*)(ws0 + WS_RSQ) + MTOK;
      for (int i = (int)blockIdx.x * NTHREADS + tid; i < 7 * MTOK; i += G * NTHREADS) rsq[i] = 0ull; }
    if (gridDim.y == 0x7fffu) grid.sync();
    GSYNC();
    xs0_phase(KP()->x, KP()->norm_gain, mod, HB, (unsigned long long*)(ws + WS_RSQ), NGW, wave_s);
    bias_phase(ws, NGW, wave_s);
    GSYNC();

#pragma unroll 1
    for (int l = 0; l < DEPTH; ++l) {
        const int kind = l % 3;
        const float* mod_l = mod + (size_t)l * 8 * 6144;
        const bf16* wl = (const bf16*)(ws + WS_W + (size_t)l * W_LAYER);
        const int nqkv = (kind == 2) ? 1280 : 3072, nqk = (kind == 2) ? 1280 : 2048;
        const unsigned long long* rsq1 = (const unsigned long long*)(ws + WS_RSQ) + (size_t)(2 * l) * MTOK;
        const float* bias1 = (const float*)(ws + WS_BIAS + (size_t)l * BIAS_LAYER);
        const int nkv = (kind == 2) ? 2 : 16;
        {
            pg8::Gemm g{HB, wl + W_IN / 2, MTOK, nqk, DM}; pg8::StaticOrder S; S.init(MTOK, nqk, G, (int)blockIdx.x);
            pg8::EpiQK E{QK, ws + WS_KF, nkv, rsq1, bias1, 3072};
            pg8::gemm_phase<pg8::EpiQK, pg8::StaticOrder, true, true>(lds, g, S, E, wave_s);
        }
        {
            const int vrows = (kind == 2) ? 256 : 1024;
            pg8::Gemm g{wl + W_IN / 2 + (size_t)(nqkv - vrows) * DM, HB, vrows, MTOK, DM}; pg8::StaticOrder S; S.init(vrows, MTOK, G, (int)blockIdx.x);
            pg8::EpiVT E{ws + WS_VT, nkv, (kind == 2) ? 128 : 0, rsq1, bias1 + (nqkv - vrows), 3072};
            pg8::gemm_phase<pg8::EpiVT, pg8::StaticOrder, true, true>(lds, g, S, E, wave_s);
        }
        GSYNC();
        if (kind != 0) {
            rope_phase(QK, ws + WS_KF, nkv, kind == 1 ? KP()->moba_gain : KP()->swa_gain, kind == 1, kmean, NGW, wave_s);
            GSYNC();
        }
        if (kind == 0) sb_wg_phase(QK, ws + WS_KF, ws + WS_VT, OB, G, lds, wave_s);
        else if (kind == 1) moba_wg_phase(QK, ws + WS_KF, ws + WS_VT, OB, kmean, KP()->moba_gain, G, lds, wave_s);
        else swa_wg_phase(QK, ws + WS_KF, ws + WS_VT, OB, KP()->swa_sinks, KP()->swa_gain, G, lds, wave_s);
        GSYNC();
        {
            const bf16* wo = wl + W_OUT / 2;
            pg8::Gemm g{OB, wo, MTOK, DM, DM}; pg8::StaticOrder S; S.init(MTOK, DM, G, (int)blockIdx.x);
            pg8::EpiRes E{HB, KP()->norm_gain + (size_t)(l * 2) * DM, mod_l + DM, mod_l + 2 * DM, (float*)nullptr, HB, KP()->norm_gain + (size_t)(l * 2 + 1) * DM, mod_l + 4 * DM, (unsigned long long*)(ws + WS_RSQ) + (size_t)(2 * l + 1) * MTOK};
            pg8::gemm_phase<pg8::EpiRes, pg8::StaticOrder, true, true>(lds, g, S, E, wave_s);
        }
        GSYNC();
        {
            pg8::Gemm g{HB, wl + W_GU / 2, MTOK, 2 * FF, DM}; pg8::StaticOrder S; S.init(MTOK, 2 * FF, G, (int)blockIdx.x);
            pg8::EpiGLU E{ACT, FF, (const unsigned long long*)(ws + WS_RSQ) + (size_t)(2 * l + 1) * MTOK, bias1 + 8 * 3072};
            pg8::gemm_phase<pg8::EpiGLU, pg8::StaticOrder, true, true>(lds, g, S, E, wave_s);
        }
        GSYNC();
        {
            const bool more = (l + 1 < DEPTH);
            pg8::Gemm g{ACT, wl + W_DN / 2, MTOK, DM, FF}; pg8::StaticOrder S; S.init(MTOK, DM, G, (int)blockIdx.x);
            pg8::EpiRes E{HB, KP()->norm_gain + (size_t)(l * 2 + 1) * DM, mod_l + 4 * DM, mod_l + 5 * DM, more ? (float*)nullptr : KP()->out, more ? HB : (bf16*)nullptr, KP()->norm_gain + (size_t)((l + 1) * 2) * DM, mod_l + 8 * 6144 + DM, (unsigned long long*)(ws + WS_RSQ) + (size_t)(2 * l + 2) * MTOK};
            pg8::gemm_phase<pg8::EpiRes, pg8::StaticOrder, true, true>(lds, g, S, E, wave_s);
        }
        if (l + 1 < DEPTH) GSYNC();
    }
}
#undef ws
#undef mod
#undef kmean
#undef HB
#undef OB
#undef QK
#undef VT
#undef ACT
extern "C" void kernel_launch(void* const* d_in, const int* in_sizes, int n_in, void* d_out, int out_size, void* d_ws, size_t ws_size, hipStream_t stream) {
    static int grid = 0;
    if (grid == 0) {
        if (n_in != 17 || out_size != MTOK * DM || ws_size < WS_END) { fprintf(stderr, "kernel_launch: unexpected shapes (n_in %d out %d ws %zu)\n", n_in, out_size, ws_size); grid = -1; return; }
        int dev = 0, cus = 0, per_cu = 0;
        hipGetDevice(&dev); hipDeviceGetAttribute(&cus, hipDeviceAttributeMultiprocessorCount, dev);
        if (hipFuncSetAttribute((const void*)trunk_fwd, hipFuncAttributeMaxDynamicSharedMemorySize, LDS_BYTES) != hipSuccess) { fprintf(stderr, "kernel_launch: hipFuncSetAttribute failed\n"); grid = -1; return; }
        if (hipOccupancyMaxActiveBlocksPerMultiprocessor(&per_cu, (const void*)trunk_fwd, NTHREADS, LDS_BYTES) != hipSuccess || per_cu < 1) { fprintf(stderr, "kernel_launch: occupancy query failed (%d)\n", per_cu); (void)hipGetLastError(); per_cu = 1; }
        grid = cus * per_cu;
    }
    if (grid < 0) return;
    Params p{};
    const float** pp = (const float**)&p;
    for (int i = 0; i < 17; ++i) pp[i] = (const float*)d_in[i];
    p.out = (float*)d_out; p.ws = (unsigned char*)d_ws;
    if (hipMemsetAsync((char*)d_ws + WS_BAR, 0, 16384, stream) != hipSuccess) { fprintf(stderr, "kernel_launch: memset failed\n"); return; }
    void* args[] = {&p};
    hipError_t e = hipLaunchCooperativeKernel((const void*)trunk_fwd, dim3(grid), dim3(NTHREADS), args, LDS_BYTES, stream);
    if (e != hipSuccess) fprintf(stderr, "cooperative launch failed: %s (grid %d)\n", hipGetErrorString(e), grid);
}
```

```cpp
#include <hip/hip_runtime.h>
#include <hip/hip_cooperative_groups.h>
#include <cstdio>
#include <cstdint>
namespace cg = cooperative_groups;
namespace pg8 {
#define PG8_LAS __attribute__((address_space(3)))
typedef unsigned short bf16_t;
typedef short bf16x8 __attribute__((ext_vector_type(8)));
typedef float f32x4 __attribute__((ext_vector_type(4)));
typedef unsigned u32x4 __attribute__((ext_vector_type(4)));
constexpr int BM = 256, BK = 64, HALF = 128, HTB = HALF * BK * 2  , STAGE_BYTES = 8 * HTB, NXCD = 8, WGM = 8;

__host__ __device__ __forceinline__ int lds_byte(int r, int c) { const int st = (r >> 4) * 2 + (c >> 5), rr = r & 15, cc = c & 31, ob = rr * 64 + cc * 2; return st * 1024 + (ob ^ (((ob >> 9) & 1) << 5)); }
__host__ __device__ __forceinline__ void stage_rc(int b, int& R, int& C) { const int st = b / 1024, sb = b % 1024, swz = sb ^ (((sb >> 9) & 1) << 5); R = (st >> 1) * 16 + swz / 64; C = (st & 1) * 32 + (swz % 64) / 2; }
__host__ __device__ __forceinline__ int perm32(int rho) { const int n = rho >> 4, i = rho & 15; return 8 * (i >> 2) + 4 * n + (i & 3); }

struct Unit { int pm, pn; };
struct Gemm { const bf16_t* A; const bf16_t* Bt; int M, N, K; };

struct StaticOrder {
    int nM, nN, nwg, G, c;
    __host__ __device__ void init(int M, int N, int G_, int c_) { nM = M / BM; nN = N / BM; nwg = nM * nN; G = G_; c = c_; }
    __host__ __device__ bool next(int i, Unit& u) const {
        const long L = (long)i * G + c; if (L >= nwg) return false;
        int wgid = (int)L; { const int q = nwg / NXCD, r = nwg % NXCD, xcd = wgid % NXCD, off = wgid / NXCD; wgid = (xcd < r ? xcd * (q + 1) : r * (q + 1) + (xcd - r) * q) + off; }
        const int nig = WGM * nN, gid = wgid / nig, fm = gid * WGM, gsz = (nM - fm) < WGM ? (nM - fm) : WGM;
        u.pm = fm + ((wgid % nig) % gsz); u.pn = (wgid % nig) / gsz; return true;
    }
    __device__ __forceinline__ void a_ready(const Unit&) const {}
    __device__ __forceinline__ void done(const Unit&) const {}
};

__device__ __forceinline__ unsigned cvt_pk_bf16(float lo, float hi) { unsigned r; asm volatile("v_cvt_pk_bf16_f32 %0, %1, %2" : "=v"(r) : "v"(lo), "v"(hi)); return r; }
typedef float f32x2 __attribute__((ext_vector_type(2)));
struct EpiBf16 {
    static constexpr bool PERM = true, AFTER_DRAIN = false;
    bf16_t* O; int ldc;
    __device__ __forceinline__ void operator()(const f32x4 (&acc)[2][2][4][2], const Unit& u, int wr, int wc, int fr, int fq) const {
        const int row0 = u.pm * BM + wr * 64 + fr; const int col0 = u.pn * BM + wc * 32 + 8 * fq;
#pragma unroll
        for (int ai = 0; ai < 2; ++ai)
#pragma unroll
            for (int m = 0; m < 4; ++m) { bf16_t* rowp = O + (size_t)(row0 + ai * HALF + m * 16) * ldc + col0;
#pragma unroll
                for (int bj = 0; bj < 2; ++bj) { const f32x4 v0 = acc[ai][bj][m][0], v1 = acc[ai][bj][m][1];
                    u32x4 w; w.x = cvt_pk_bf16(v0[0], v0[1]); w.y = cvt_pk_bf16(v0[2], v0[3]); w.z = cvt_pk_bf16(v1[0], v1[1]); w.w = cvt_pk_bf16(v1[2], v1[3]);
                    *(u32x4*)(rowp + bj * HALF) = w; } }
    }
};
__device__ __forceinline__ int pi32(int m) { return (m & 19) | ((m & 4) << 1) | ((m & 8) >> 1); }
struct EpiQK {
    static constexpr bool PERM = true, AFTER_DRAIN = false;
    bf16_t* Q; unsigned char* KF; int nkv; const unsigned long long* rowsq; const float* bias; int ldb;
    __device__ __forceinline__ void operator()(const f32x4 (&acc)[2][2][4][2], const Unit& u, int wr, int wc, int fr, int fq) const {
        const int row0 = u.pm * BM + wr * 64 + fr; const int col0 = u.pn * BM + wc * 32 + 8 * fq;
        f32x4 bv[2][2];
        { const float* bp = bias + (size_t)((u.pm * BM) >> 12) * ldb + col0;
#pragma unroll
          for (int bj = 0; bj < 2; ++bj) { bv[bj][0] = *(const f32x4*)(bp + bj * HALF); bv[bj][1] = *(const f32x4*)(bp + bj * HALF + 4); } }
#pragma unroll
        for (int ai = 0; ai < 2; ++ai)
#pragma unroll
            for (int m = 0; m < 4; ++m) { const int row = row0 + ai * HALF + m * 16; const float rstd = __builtin_amdgcn_rsqf((float)rowsq[row] * (1.f / 1024.f / 4294967296.f) + 1e-6f);
#pragma unroll
                for (int bj = 0; bj < 2; ++bj) { const f32x4 v0 = acc[ai][bj][m][0] * rstd + bv[bj][0], v1 = acc[ai][bj][m][1] * rstd + bv[bj][1]; const int col = col0 + bj * HALF;
                    u32x4 w; w.x = cvt_pk_bf16(v0[0], v0[1]); w.y = cvt_pk_bf16(v0[2], v0[3]); w.z = cvt_pk_bf16(v1[0], v1[1]); w.w = cvt_pk_bf16(v1[2], v1[3]);
                    if (col < 1024) *(u32x4*)(Q + (size_t)row * 1024 + col) = w;
                    else { const int kc = col - 1024, head = kc >> 6, c = (kc & 63) >> 3;
                        if (head < nkv) { const int b = row >> 12, s = row & 4095;
                            *(u32x4*)(KF + ((size_t)((b * nkv + head) * 128 + (s >> 5)) << 12) + (c >> 1) * 1024 + ((c & 1) * 32 + pi32(s & 31)) * 16) = w; } } } }
    }
};
struct EpiVT {
    static constexpr bool PERM = true, AFTER_DRAIN = false;
    unsigned char* VF; int nkv; int row_off; const unsigned long long* rowsq; const float* bias; int ldb;
    __device__ __forceinline__ void operator()(const f32x4 (&acc)[2][2][4][2], const Unit& u, int wr, int wc, int fr, int fq) const {
        const int row0 = u.pm * BM + wr * 64 + fr - row_off; const int col0 = u.pn * BM + wc * 32 + 8 * fq;
        f32x4 r0[2], r1[2];
#pragma unroll
        for (int bj = 0; bj < 2; ++bj) { const unsigned long long* rp = rowsq + col0 + bj * HALF;
#pragma unroll
            for (int e = 0; e < 4; ++e) { r0[bj][e] = __builtin_amdgcn_rsqf((float)rp[e] * (1.f / 1024.f / 4294967296.f) + 1e-6f); r1[bj][e] = __builtin_amdgcn_rsqf((float)rp[4 + e] * (1.f / 1024.f / 4294967296.f) + 1e-6f); } }
#pragma unroll
        for (int ai = 0; ai < 2; ++ai)
#pragma unroll
            for (int m = 0; m < 4; ++m) { const int f = row0 + ai * HALF + m * 16; if (f < 0) continue; const int kvh = f >> 6, d = f & 63;
#pragma unroll
                for (int bj = 0; bj < 2; ++bj) { const int col = col0 + bj * HALF; const float bs = bias[(size_t)(col >> 12) * ldb + f + row_off];
                    const f32x4 v0 = acc[ai][bj][m][0] * r0[bj] + bs, v1 = acc[ai][bj][m][1] * r1[bj] + bs;
                    u32x4 w; w.x = cvt_pk_bf16(v0[0], v0[1]); w.y = cvt_pk_bf16(v0[2], v0[3]); w.z = cvt_pk_bf16(v1[0], v1[1]); w.w = cvt_pk_bf16(v1[2], v1[3]);
                    const int b = col >> 12, s = col & 4095, x = (s & 31) >> 3;
                    *(u32x4*)(VF + ((size_t)((b * nkv + kvh) * 128 + (s >> 5)) << 12) + ((d >> 5) * 2 + (x >> 1)) * 1024 + ((x & 1) * 32 + (d & 31)) * 16) = w; } }
    }
};
struct EpiRes {
    static constexpr bool PERM = true, AFTER_DRAIN = false;
    const bf16_t* xs_in; const float* gain_c; const float* sc_c; const float* gate; float* fout; bf16_t* xs; const float* gain_n; const float* sc_n; unsigned long long* rowsq;
    __device__ __forceinline__ void operator()(const f32x4 (&acc)[2][2][4][2], const Unit& u, int wr, int wc, int fr, int fq) const {
        const int row0 = u.pm * BM + wr * 64 + fr; const int col0 = u.pn * BM + wc * 32 + 8 * fq;
        const int x32 = ((fq * 16 + fr) ^ 32) << 2; const int bb = (u.pm * BM) >> 12;
        float ssq[8];
#pragma unroll
        for (int i = 0; i < 8; ++i) ssq[i] = 0.f;
#pragma unroll
        for (int bj = 0; bj < 2; ++bj) { const int col = col0 + bj * HALF;
            const f32x4 g0 = *(const f32x4*)(gate + (size_t)bb * 6144 + col), g1 = *(const f32x4*)(gate + (size_t)bb * 6144 + col + 4);
            f32x4 c0 = *(const f32x4*)(gain_c + col) * (*(const f32x4*)(sc_c + (size_t)bb * 6144 + col) + 1.f), c1 = *(const f32x4*)(gain_c + col + 4) * (*(const f32x4*)(sc_c + (size_t)bb * 6144 + col + 4) + 1.f);
#pragma unroll
            for (int e = 0; e < 4; ++e) { c0[e] = __builtin_amdgcn_rcpf(c0[e]); c1[e] = __builtin_amdgcn_rcpf(c1[e]); }
            f32x4 n0 = c0, n1 = c1;
            if (xs) { n0 = *(const f32x4*)(gain_n + col) * (*(const f32x4*)(sc_n + (size_t)bb * 6144 + col) + 1.f); n1 = *(const f32x4*)(gain_n + col + 4) * (*(const f32x4*)(sc_n + (size_t)bb * 6144 + col + 4) + 1.f); }
#pragma unroll
            for (int ai = 0; ai < 2; ++ai)
#pragma unroll
                for (int m = 0; m < 4; ++m) { const size_t e0 = (size_t)(row0 + ai * HALF + m * 16) * 1024 + col;
                    const u32x4 r = *(const u32x4*)(xs_in + e0);
                    const f32x4 x0 = (f32x4){__builtin_bit_cast(float, r.x << 16), __builtin_bit_cast(float, r.x & 0xffff0000u), __builtin_bit_cast(float, r.y << 16), __builtin_bit_cast(float, r.y & 0xffff0000u)} * c0;
                    const f32x4 x1 = (f32x4){__builtin_bit_cast(float, r.z << 16), __builtin_bit_cast(float, r.z & 0xffff0000u), __builtin_bit_cast(float, r.w << 16), __builtin_bit_cast(float, r.w & 0xffff0000u)} * c1;
                    const f32x4 y0 = x0 + g0 * acc[ai][bj][m][0], y1 = x1 + g1 * acc[ai][bj][m][1];
                    if (fout) { __builtin_nontemporal_store(y0, (f32x4*)(fout + e0)); __builtin_nontemporal_store(y1, (f32x4*)(fout + e0 + 4)); }
                    if (xs) { const f32x4 z0 = y0 * n0, z1 = y1 * n1;
                        u32x4 w; w.x = cvt_pk_bf16(z0[0], z0[1]); w.y = cvt_pk_bf16(z0[2], z0[3]); w.z = cvt_pk_bf16(z1[0], z1[1]); w.w = cvt_pk_bf16(z1[2], z1[3]);
                        *(u32x4*)(xs + e0) = w;
                        ssq[ai * 4 + m] += (y0[0] * y0[0] + y0[1] * y0[1]) + (y0[2] * y0[2] + y0[3] * y0[3]) + (y1[0] * y1[0] + y1[1] * y1[1]) + (y1[2] * y1[2] + y1[3] * y1[3]); } } }
        if (xs) {
#pragma unroll
            for (int i = 0; i < 8; ++i) { float q = ssq[i];
                q += __builtin_bit_cast(float, __builtin_amdgcn_ds_swizzle(__builtin_bit_cast(int, q), (16 << 10) | 0x1f));
                q += __builtin_bit_cast(float, __builtin_amdgcn_ds_bpermute(x32, __builtin_bit_cast(int, q)));
                if (fq == 0) atomicAdd(rowsq + row0 + (i >> 2) * HALF + (i & 3) * 16, (unsigned long long)(q * 4294967296.f)); } }
    }
};
struct EpiGLU {
    static constexpr bool PERM = false, AFTER_DRAIN = false;
    bf16_t* O; int ldc; const unsigned long long* rowsq; const float* bias;
    __device__ __forceinline__ void operator()(const f32x4 (&acc)[2][2][4][2], const Unit& u, int wr, int wc, int fr, int fq) const {
        const int row0 = u.pm * BM + wr * 64 + fr; const int col0 = u.pn * 128 + wc * 16 + 4 * fq; const int bcol0 = u.pn * BM + wc * 32 + 4 * fq;
        f32x4 bv[2][2];
        { const float* bp = bias + (size_t)((u.pm * BM) >> 12) * 5632 + bcol0;
#pragma unroll
          for (int bj = 0; bj < 2; ++bj) { bv[bj][0] = *(const f32x4*)(bp + bj * HALF); bv[bj][1] = *(const f32x4*)(bp + bj * HALF + 16); } }
#pragma unroll
        for (int ai = 0; ai < 2; ++ai)
#pragma unroll
            for (int m = 0; m < 4; ++m) { const int row = row0 + ai * HALF + m * 16; bf16_t* rowp = O + (size_t)row * ldc + col0;
                const float rstd = __builtin_amdgcn_rsqf((float)rowsq[row] * (1.f / 1024.f / 4294967296.f) + 1e-6f);
#pragma unroll
                for (int bj = 0; bj < 2; ++bj) { const f32x4 g = acc[ai][bj][m][0] * rstd + bv[bj][0], up = acc[ai][bj][m][1] * rstd + bv[bj][1]; float r[4];
#pragma unroll
                    for (int e = 0; e < 4; ++e) r[e] = __fdividef(g[e], 1.f + __expf(-g[e])) * up[e];
                    uint2 w; w.x = cvt_pk_bf16(r[0], r[1]); w.y = cvt_pk_bf16(r[2], r[3]);
                    *(uint2*)(rowp + bj * 64) = w; } }
    }
};
template <class Epi, class Sched, bool ALIGN_EPI = false, bool SP2 = false>
__device__ __forceinline__ void gemm_phase(PG8_LAS unsigned char* lds, const Gemm g, const Sched& S, const Epi& E, const int wave_s) {
    int lid_; asm volatile("v_mbcnt_lo_u32_b32 %0, -1, 0\n\tv_mbcnt_hi_u32_b32 %0, -1, %0" : "=v"(lid_)); const int tid_ = wave_s * 64 + lid_;
    const int tid = tid_, wid = __builtin_amdgcn_readfirstlane(tid >> 6), lane = tid & 63, wr = wid >> 2, wc = wid & 3, fr = lane & 15, fq = lane >> 4;
    const int K = g.K, nt = K / BK;
    unsigned voffA[2], voffB[2];
#pragma unroll
    for (int i = 0; i < 2; ++i) { int R, C; stage_rc(tid * 16 + i * 8192, R, C); const int Rb = Epi::PERM ? ((R & ~31) + perm32(R & 31)) : R;
        voffA[i] = (unsigned)(R * K + C) * 2u; voffB[i] = (unsigned)(Rb * K + C) * 2u; }
    const size_t kstep = (size_t)(BK * 2);
    const size_t hstep = (size_t)HALF * K * 2;
    const size_t tstep = 2 * hstep;
    const unsigned ldsw = (unsigned)wid * 1024u;
    const int aoff = lds_byte(wr * 64 + fr, fq * 8), boff = lds_byte(wc * 32 + fr, fq * 8);
#define PG8_SA(b, h) (((b) * 2 + (h)) * HTB)
#define PG8_SB(b, h) ((4 + (b) * 2 + (h)) * HTB)
#define PG8_STAGE(bufoff, gbase, voff) do { _Pragma("unroll") for (int _i = 0; _i < 2; ++_i) \
        __builtin_amdgcn_global_load_lds((const unsigned*)((const char*)(gbase) + (voff)[_i]), (PG8_LAS unsigned*)(lds + (bufoff) + ldsw + _i * 8192), 16, 0, 0); } while (0)
#define PG8_LDA(dst, b, h) do { _Pragma("unroll") for (int m = 0; m < 4; ++m) _Pragma("unroll") for (int k = 0; k < 2; ++k) dst[m][k] = *(const PG8_LAS bf16x8*)(lds + PG8_SA(b, h) + aoff + m * 2048 + k * 1024); } while (0)
#define PG8_LDB(dst, b, h) do { _Pragma("unroll") for (int n = 0; n < 2; ++n) _Pragma("unroll") for (int k = 0; k < 2; ++k) dst[n][k] = *(const PG8_LAS bf16x8*)(lds + PG8_SB(b, h) + boff + n * 2048 + k * 1024); } while (0)
#define PG8_MMA(ai, bj, At, Bt) do { __builtin_amdgcn_s_setprio(1); _Pragma("unroll") for (int m = 0; m < 4; ++m) _Pragma("unroll") for (int n = 0; n < 2; ++n) _Pragma("unroll") for (int k = 0; k < 2; ++k) \
        acc[ai][bj][m][n] = __builtin_amdgcn_mfma_f32_16x16x32_bf16(Bt[n][k], At[m][k], acc[ai][bj][m][n], 0, 0, 0); __builtin_amdgcn_s_setprio(0); } while (0)
#define PG8_WAIT_V(n) asm volatile("s_waitcnt vmcnt(" #n ")" ::: "memory")
#define PG8_WAIT_L(n) asm volatile("s_waitcnt lgkmcnt(" #n ")" ::: "memory")
#define PG8_BAR __builtin_amdgcn_s_barrier()
#define PG8_SCHED __builtin_amdgcn_sched_barrier(0)
    Unit cur, nxt; int ui = 0;
    if (!S.next(0, cur)) return;
    f32x4 acc[2][2][4][2];
#pragma unroll
    for (int a = 0; a < 2; ++a)
#pragma unroll
        for (int b = 0; b < 2; ++b)
#pragma unroll
            for (int m = 0; m < 4; ++m)
#pragma unroll
                for (int n = 0; n < 2; ++n) acc[a][b][m][n] = (f32x4){0.f, 0.f, 0.f, 0.f};
    bf16x8 At[4][2], B0[2][2], B1[2][2];
    const char* cA = (const char*)g.A + (size_t)cur.pm * tstep; const char* cB = (const char*)g.Bt + (size_t)cur.pn * tstep;
    S.a_ready(cur);
    if constexpr (SP2) {
        PG8_STAGE(PG8_SB(0, 0), cB, voffB); PG8_STAGE(PG8_SB(0, 1), cB + hstep, voffB); PG8_STAGE(PG8_SA(0, 0), cA, voffA); PG8_STAGE(PG8_SA(0, 1), cA + hstep, voffA);
        if (wr == 1) PG8_BAR;
        PG8_WAIT_V(2); PG8_BAR;
        PG8_STAGE(PG8_SB(1, 0), cB + kstep, voffB); PG8_STAGE(PG8_SA(1, 0), cA + kstep, voffA); PG8_STAGE(PG8_SB(1, 1), cB + hstep + kstep, voffB);
        PG8_WAIT_V(6); PG8_BAR;
    } else {
        PG8_STAGE(PG8_SB(0, 0), cB, voffB); PG8_STAGE(PG8_SA(0, 0), cA, voffA); PG8_STAGE(PG8_SB(0, 1), cB + hstep, voffB); PG8_STAGE(PG8_SA(0, 1), cA + hstep, voffA);
        if (wr == 1) PG8_BAR;
        PG8_WAIT_V(4); PG8_BAR;
        PG8_STAGE(PG8_SB(1, 0), cB + kstep, voffB); PG8_STAGE(PG8_SA(1, 0), cA + kstep, voffA); PG8_STAGE(PG8_SB(1, 1), cB + hstep + kstep, voffB);
        PG8_WAIT_V(6); PG8_BAR;
    }
    for (;;) {
        const bool has_next = S.next(ui + 1, nxt);
        const char* nA = has_next ? (const char*)g.A + (size_t)nxt.pm * tstep : cA; const char* nB = has_next ? (const char*)g.Bt + (size_t)nxt.pn * tstep : cB;
        for (int t = 0; t < nt; t += 2) {
            const bool last = (t == nt - 2);
            const char* a1 = cA + (size_t)(t + 1) * kstep;
            const char* a2 = last ? nA : cA + (size_t)(t + 2) * kstep; const char* b2 = last ? nB : cB + (size_t)(t + 2) * kstep;
            const char* a3 = a2 + kstep; const char* b3 = b2 + kstep;
            if (last && has_next) S.a_ready(nxt);
            if constexpr (SP2) {
            PG8_LDB(B0, 0, 0); PG8_LDB(B1, 0, 1); PG8_SCHED; PG8_LDA(At, 0, 0); PG8_STAGE(PG8_SA(1, 1), a1 + hstep, voffA);
            PG8_WAIT_V(8); PG8_WAIT_L(0); PG8_BAR; PG8_MMA(0, 0, At, B0); PG8_MMA(0, 1, At, B1); PG8_BAR; PG8_SCHED;
            PG8_LDA(At, 0, 1); PG8_STAGE(PG8_SB(0, 0), b2, voffB); PG8_STAGE(PG8_SB(0, 1), b2 + hstep, voffB); PG8_STAGE(PG8_SA(0, 0), a2, voffA);
            PG8_WAIT_V(8); PG8_WAIT_L(0); PG8_BAR; PG8_MMA(1, 0, At, B0); PG8_MMA(1, 1, At, B1); PG8_BAR; PG8_SCHED;
            PG8_LDB(B0, 1, 0); PG8_LDB(B1, 1, 1); PG8_SCHED; PG8_LDA(At, 1, 0); PG8_STAGE(PG8_SA(0, 1), a2 + hstep, voffA);
            PG8_WAIT_V(8); PG8_WAIT_L(0); PG8_BAR; PG8_MMA(0, 0, At, B0); PG8_MMA(0, 1, At, B1); PG8_BAR; PG8_SCHED;
            PG8_LDA(At, 1, 1); PG8_STAGE(PG8_SB(1, 0), b3, voffB); PG8_STAGE(PG8_SB(1, 1), b3 + hstep, voffB); PG8_STAGE(PG8_SA(1, 0), a3, voffA);
            PG8_WAIT_V(8); PG8_WAIT_L(0); PG8_BAR; PG8_MMA(1, 0, At, B0); PG8_MMA(1, 1, At, B1); PG8_BAR; PG8_SCHED;
            } else {
            PG8_LDB(B0, 0, 0); PG8_SCHED; PG8_LDA(At, 0, 0); PG8_STAGE(PG8_SA(1, 1), a1 + hstep, voffA);
            PG8_WAIT_L(8); PG8_BAR; PG8_WAIT_L(0); PG8_MMA(0, 0, At, B0); PG8_BAR; PG8_SCHED;
            PG8_LDB(B1, 0, 1); PG8_STAGE(PG8_SB(0, 0), b2, voffB);
            PG8_BAR; PG8_WAIT_L(0); PG8_MMA(0, 1, At, B1); PG8_BAR;
            PG8_LDA(At, 0, 1); PG8_STAGE(PG8_SA(0, 0), a2, voffA);
            PG8_BAR; PG8_WAIT_L(0); PG8_MMA(1, 0, At, B0); PG8_BAR; PG8_SCHED;
            PG8_STAGE(PG8_SB(0, 1), b2 + hstep, voffB);
            PG8_WAIT_V(6); PG8_BAR; PG8_MMA(1, 1, At, B1); PG8_BAR;
            PG8_LDB(B0, 1, 0); PG8_SCHED; PG8_LDA(At, 1, 0); PG8_STAGE(PG8_SA(0, 1), a2 + hstep, voffA);
            PG8_WAIT_L(8); PG8_BAR; PG8_WAIT_L(0); PG8_MMA(0, 0, At, B0); PG8_BAR; PG8_SCHED;
            PG8_LDB(B1, 1, 1); PG8_STAGE(PG8_SB(1, 0), b3, voffB);
            PG8_BAR; PG8_WAIT_L(0); PG8_MMA(0, 1, At, B1); PG8_BAR;
            PG8_LDA(At, 1, 1); PG8_STAGE(PG8_SA(1, 0), a3, voffA);
            PG8_BAR; PG8_WAIT_L(0); PG8_MMA(1, 0, At, B0); PG8_BAR; PG8_SCHED;
            PG8_STAGE(PG8_SB(1, 1), b3 + hstep, voffB);
            PG8_WAIT_V(6); PG8_BAR; PG8_MMA(1, 1, At, B1); PG8_BAR;
            }
        }
        if constexpr (ALIGN_EPI) { if (wr == 0) PG8_BAR; }
        if constexpr (!Epi::AFTER_DRAIN) { E(acc, cur, wr, wc, fr, fq); S.done(cur); }
        if (!has_next) break;
#pragma unroll
        for (int a = 0; a < 2; ++a)
#pragma unroll
            for (int b = 0; b < 2; ++b)
#pragma unroll
                for (int m = 0; m < 4; ++m)
#pragma unroll
                    for (int n = 0; n < 2; ++n) acc[a][b][m][n] = (f32x4){0.f, 0.f, 0.f, 0.f};
        cur = nxt; cA = nA; cB = nB; ++ui;
        if constexpr (ALIGN_EPI) { if (wr == 1) PG8_BAR; }
    }
    PG8_WAIT_V(0);
    if constexpr (!ALIGN_EPI) { if (wr == 0) PG8_BAR; }
    PG8_BAR;
    if constexpr (Epi::AFTER_DRAIN) { E.fused(acc, cur, wr, wc, fr, fq, lds, wid, lane); S.done(cur); }
#undef PG8_SA
#undef PG8_SB
#undef PG8_STAGE
#undef PG8_LDA
#undef PG8_LDB
#undef PG8_MMA
#undef PG8_WAIT_V
#undef PG8_WAIT_L
#undef PG8_BAR
#undef PG8_SCHED
}
}
constexpr int NB = 8, SEQ = 4096, DM = 1024, NH = 16, HD = 64, FF = 2816, MTOK = NB * SEQ, DEPTH = 4;
constexpr int NWAVES = 8, NTHREADS = 512;
constexpr int LDS_BYTES = 147456;
constexpr float EPS = 1e-6f;
constexpr size_t MiB = 1u << 20;
constexpr size_t WS_MOD = 0;
constexpr size_t WS_KMEAN = 1 * MiB;
constexpr size_t WS_W = 2 * MiB, W_LAYER = 25 * MiB;
constexpr size_t W_IN = 0, W_OUT = 6 * MiB, W_GU = 8 * MiB, W_DN = 19 * MiB;
constexpr size_t WS_H = 104 * MiB;
constexpr size_t WS_O = 168 * MiB;
constexpr size_t WS_QK = 232 * MiB;
constexpr size_t WS_KF = 296 * MiB;
constexpr size_t WS_VT = 360 * MiB;
constexpr size_t WS_ACT = 232 * MiB;
constexpr size_t WS_RSQ = 424 * MiB;
constexpr size_t WS_BIAS = 426 * MiB;
constexpr size_t BIAS_LAYER = 8 * (3072 + 5632) * 4;
constexpr size_t WS_END = 430 * MiB;
static_assert(WS_ACT + (size_t)MTOK * FF * 2 <= WS_END && W_DN + (size_t)DM * FF * 2 <= W_LAYER, "ws map");

#define GAS __attribute__((address_space(1)))
#define LAS __attribute__((address_space(3)))
#define DI __device__ __forceinline__
#define PHASE_IDS() int lane_; asm volatile("v_mbcnt_lo_u32_b32 %0, -1, 0\n\tv_mbcnt_hi_u32_b32 %0, -1, %0" : "=v"(lane_)); const int lane = lane_, wave = wave_s; int gw_ = (int)blockIdx.x * NWAVES + wave; asm volatile("" : "+s"(gw_)); const int gw = gw_; const int x32 = (lane ^ 32) << 2; (void)gw; (void)lane; (void)x32
typedef unsigned short bf16;
typedef unsigned v4u __attribute__((ext_vector_type(4)));
typedef float f32x4 __attribute__((ext_vector_type(4)));
typedef float f32x16 __attribute__((ext_vector_type(16)));
typedef short bf16x8 __attribute__((ext_vector_type(8)));
typedef __bf16 bf16x2_t __attribute__((ext_vector_type(2)));
typedef float f32x2_t __attribute__((ext_vector_type(2)));
#define LDS_WAIT() asm volatile("s_waitcnt lgkmcnt(0)" ::: "memory")
constexpr float SC2 = 0.125f * 1.4426950408889634f;
#define MFMA32(a, b, c) __builtin_amdgcn_mfma_f32_32x32x16_bf16((a), (b), (c), 0, 0, 0)
DI unsigned cvtpk(float lo, float hi) { f32x2_t v = {lo, hi}; bf16x2_t b = __builtin_convertvector(v, bf16x2_t); return __builtin_bit_cast(unsigned, b); }
DI float bf2f(unsigned short u) { return __builtin_bit_cast(float, (unsigned)u << 16); }
template <int MASK> DI float swz_xor(float v) { return __builtin_bit_cast(float, __builtin_amdgcn_ds_swizzle(__builtin_bit_cast(int, v), (MASK << 10) | 0x1f)); }
DI float bperm(float v, int x32) { return __builtin_bit_cast(float, __builtin_amdgcn_ds_bpermute(x32, __builtin_bit_cast(int, v))); }
DI int bperm_i(int v, int x32) { return __builtin_amdgcn_ds_bpermute(x32, v); }
DI float wave_sum(float v, int x32) {
    v += swz_xor<1>(v); v += swz_xor<2>(v); v += swz_xor<4>(v); v += swz_xor<8>(v); v += swz_xor<16>(v); v += bperm(v, x32);
    return v;
}

#define RLX_AGENT __ATOMIC_RELAXED, __HIP_MEMORY_SCOPE_AGENT
constexpr size_t WS_BAR = 1536 * 1024;
constexpr int MISC_OFF = 131072 + 320;
#define XB_TMO      128
#define XB_XCNT(j)  (256  + 64 * (j))
#define XB_XSUB(j)  (1280 + 64 * (j))
#define XB_XGEN(j)  (2304 + 64 * (j))
#define XB_TOP      3328
#define XB_TOPGEN   3392
#define XCD_BAR_WORDS 3456
#define XB_SPIN_CAP (1u << 18)

__device__ __forceinline__ unsigned xb_ld(unsigned* p)              { return __hip_atomic_load(p, __ATOMIC_RELAXED, __HIP_MEMORY_SCOPE_AGENT); }
__device__ __forceinline__ unsigned xb_add(unsigned* p, unsigned v) { return __hip_atomic_fetch_add(p, v, __ATOMIC_RELAXED, __HIP_MEMORY_SCOPE_AGENT); }
__device__ __forceinline__ unsigned xb_xcc_id() { return (unsigned)__builtin_amdgcn_s_getreg((3 << 11) | 20) & 0xFu; }
#define XB_SPIN(cond, bar) do { unsigned _sp = 0; while (cond) { __builtin_amdgcn_s_sleep(1); \
    if ((++_sp & 255u) == 0u) { if (xb_ld(&(bar)[XB_TMO])) break; if (_sp > XB_SPIN_CAP) { atomicAdd(&(bar)[XB_TMO], 1u); break; } } } } while (0)

struct XcdBarrier {
    unsigned* bar; unsigned x;
    volatile LAS unsigned* st;
};

__device__ __forceinline__ XcdBarrier xcd_barrier_post(unsigned* bar, volatile LAS unsigned* st) {
    XcdBarrier b; b.bar = bar; b.x = xb_xcc_id(); b.st = st;
    if (threadIdx.x == 0) (void)xb_add(&bar[XB_XCNT(b.x)], 1u);
    return b;
}
__device__ __forceinline__ void xcd_barrier_complete(unsigned* bar, unsigned x, unsigned& nloc, unsigned& nx) {
    const unsigned G = gridDim.x * gridDim.y * gridDim.z;
    unsigned sum, cnt, mine, sp = 0u;
    for (;;) {
        sum = 0u; cnt = 0u; mine = 0u;
#pragma unroll
        for (unsigned j = 0; j < 16; ++j) { const unsigned c = xb_ld(&bar[XB_XCNT(j)]); sum += c; cnt += (c > 0u) ? 1u : 0u; mine = (j == x) ? c : mine; }
        if (sum == G) break;
        __builtin_amdgcn_s_sleep(1);
        if ((++sp & 255u) == 0u) { if (xb_ld(&bar[XB_TMO])) break; if (sp > XB_SPIN_CAP) { atomicAdd(&bar[XB_TMO], 1u); break; } }
    }
    nloc = mine > 0u ? mine : 1u; nx = cnt > 0u ? cnt : 1u;
}

__device__ __forceinline__ void xcd_barrier(const XcdBarrier& b, const bool leader) {
    asm volatile("s_waitcnt vmcnt(0)" ::: "memory");
    __syncthreads();
    if (leader) {
        unsigned* bar = b.bar; unsigned bx = b.x; asm volatile("" : "+s"(bx), "+s"(bar));
        __builtin_amdgcn_s_waitcnt(0);
        unsigned nloc = b.st[0], nx = b.st[1];
        if (nloc == 0u) { xcd_barrier_complete(bar, bx, nloc, nx); b.st[0] = nloc; b.st[1] = nx; }
        const unsigned old = xb_add(&bar[XB_XSUB(bx)], 1u);
        const unsigned gen = old / nloc;
        if (old + 1u == (gen + 1u) * nloc) {
            __builtin_amdgcn_fence(__ATOMIC_RELEASE, "agent");
            asm volatile("s_waitcnt vmcnt(0)" ::: "memory");
            const unsigned og = xb_add(&bar[XB_TOP], 1u);
            const unsigned tg = og / nx;
            if (og + 1u == (tg + 1u) * nx) xb_add(&bar[XB_TOPGEN], 1u);
            else XB_SPIN(xb_ld(&bar[XB_TOPGEN]) == tg, bar);
            __builtin_amdgcn_fence(__ATOMIC_ACQUIRE, "agent");
            xb_add(&bar[XB_XGEN(bx)], 1u);
            asm volatile("s_waitcnt vmcnt(0)" ::: "memory");
        } else {
            XB_SPIN(xb_ld(&bar[XB_XGEN(bx)]) == gen, bar);
            __builtin_amdgcn_fence(__ATOMIC_ACQUIRE, "agent");
            asm volatile("s_waitcnt vmcnt(0)" ::: "memory");
        }
    }
    __syncthreads();
}

struct Params {
    const float *x, *c, *ada_w, *ada_b, *norm_gain, *ffn_g, *ffn_u, *ffn_d, *sb_in, *sb_out, *moba_in, *moba_gain, *moba_out, *swa_in, *swa_gain, *swa_sinks, *swa_out;
    float* out; unsigned char* ws;
};

typedef const Params __attribute__((address_space(4))) CParams;
DI CParams* kp_opaque() { CParams* r = (CParams*)__builtin_amdgcn_kernarg_segment_ptr(); asm volatile("" : "+s"(r)); return r; }
#define KP() kp_opaque()
DI void transpose_item(const float* W, int K, int N, bf16* WT, int mode, LAS float* scr, int kb, int nb, int lane) {
    const int k0 = 64 * kb, n0 = 32 * nb;
    {
        const int ks = lane >> 3, n4 = (lane & 7) * 4; f32x4 t[8];
#pragma unroll
        for (int i = 0; i < 8; ++i) t[i] = __builtin_nontemporal_load((const f32x4*)(W + (size_t)(k0 + 8 * i + ks) * N + n0 + n4));
#pragma unroll
        for (int i = 0; i < 8; ++i) { LAS float* d = scr + (8 * i + ks) * 33 + n4; d[0] = t[i].x; d[1] = t[i].y; d[2] = t[i].z; d[3] = t[i].w; }
    }
    LDS_WAIT(); asm volatile("" ::: "memory");
    const int c = lane & 7;
#pragma unroll
    for (int j = 0; j < 4; ++j) { const int n = (lane >> 3) + 8 * j; const LAS float* s = scr + (8 * c) * 33 + n;
        v4u o; o.x = cvtpk(s[0 * 33], s[1 * 33]); o.y = cvtpk(s[2 * 33], s[3 * 33]); o.z = cvtpk(s[4 * 33], s[5 * 33]); o.w = cvtpk(s[6 * 33], s[7 * 33]);
        const int nn = n0 + n; const int row = (mode == 0) ? nn : (32 * (nn >> 4) + (nn & 15) + (mode == 2 ? 16 : 0));
        *(v4u*)(WT + (size_t)row * K + k0 + 8 * c) = o; }
    LDS_WAIT(); asm volatile("" ::: "memory");
}
constexpr int IT_IN = 16 * 96, IT_OUT = 16 * 32, IT_G = 16 * 88, IT_D = 44 * 32, IT_LAYER = IT_IN + IT_OUT + 2 * IT_G + IT_D;
DI void weights_phase(const Params& p, LAS unsigned char* lds, int gw, int NGW, int wave, int lane) {
    LAS float* scr = (LAS float*)(lds + wave * 16384);
    for (int it = gw; it < DEPTH * IT_LAYER; it += NGW) {
        const int l = it / IT_LAYER; int r = it - l * IT_LAYER; const int kind = l % 3, j = l / 3;
        bf16* wl = (bf16*)(p.ws + WS_W + (size_t)l * W_LAYER);
        if (r < IT_IN) {
            const int nN = (kind == 2) ? 1280 : 3072; const int kb = r / 96, nb = r % 96; if (nb * 32 >= nN) continue;
            const float* W = (kind == 0) ? p.sb_in + (size_t)j * DM * 3072 : (kind == 1 ? p.moba_in : p.swa_in);
            transpose_item(W, DM, nN, wl + W_IN / 2, 0, scr, kb, nb, lane); continue; }
        r -= IT_IN;
        if (r < IT_OUT) { const float* W = (kind == 0) ? p.sb_out + (size_t)j * DM * DM : (kind == 1 ? p.moba_out : p.swa_out);
            transpose_item(W, DM, DM, wl + W_OUT / 2, 0, scr, r / 32, r % 32, lane); continue; }
        r -= IT_OUT;
        if (r < IT_G) { transpose_item(p.ffn_g + (size_t)l * DM * FF, DM, FF, wl + W_GU / 2, 1, scr, r / 88, r % 88, lane); continue; }
        r -= IT_G;
        if (r < IT_G) { transpose_item(p.ffn_u + (size_t)l * DM * FF, DM, FF, wl + W_GU / 2, 2, scr, r / 88, r % 88, lane); continue; }
        r -= IT_G;
        transpose_item(p.ffn_d + (size_t)l * FF * DM, FF, DM, wl + W_DN / 2, 0, scr, r / 32, r % 32, lane);
    }
}
DI void mod_phase(const Params& p, LAS unsigned char* lds, int tid, int wave, int lane, int G) {
    if ((int)blockIdx.x >= 192) return;
    float* mod = (float*)(p.ws + WS_MOD);
    LAS float* cact = (LAS float*)lds;
    LAS float* red = (LAS float*)(lds + 32768);
    for (int i = tid; i < NB * DM; i += NTHREADS) { const float v = p.c[i]; cact[i] = v / (1.f + __expf(-v)); }
    __syncthreads();
    for (int item = blockIdx.x; item < 192; item += G) {
        const int l = item / 48, n0 = (item % 48) * 128;
        const float* wp = p.ada_w + ((size_t)l * DM + wave * 128) * 6144 + n0 + 2 * lane;
        float a0[8], a1[8];
#pragma unroll
        for (int b = 0; b < 8; ++b) { a0[b] = 0.f; a1[b] = 0.f; }
#pragma unroll 16
        for (int kk = 0; kk < 128; ++kk) { const f32x2_t w = __builtin_nontemporal_load((const f32x2_t*)(wp + (size_t)kk * 6144)); const int k = wave * 128 + kk;
#pragma unroll
            for (int b = 0; b < 8; ++b) { const float cv = cact[b * DM + k]; a0[b] += cv * w.x; a1[b] += cv * w.y; } }
#pragma unroll
        for (int b = 0; b < 8; ++b) { red[(wave * 8 + b) * 128 + 2 * lane] = a0[b]; red[(wave * 8 + b) * 128 + 2 * lane + 1] = a1[b]; }
        __syncthreads();
#pragma unroll
        for (int r = 0; r < 2; ++r) { const int idx = tid + NTHREADS * r, b = idx >> 7, col = idx & 127; float s = p.ada_b[l * 6144 + n0 + col];
#pragma unroll
            for (int w = 0; w < 8; ++w) s += red[(w * 8 + b) * 128 + col];
            mod[(size_t)(l * 8 + b) * 6144 + n0 + col] = s; }
        __syncthreads();
    }
}
DI void xs0_phase(const float* xs, const float* gain, const float* mod_l, bf16* h, unsigned long long* rowsq, int NGW, const int wave_s) {
    PHASE_IDS();
    for (int m0 = gw; m0 < MTOK; m0 += 4 * NGW) {
        f32x4 v[4][4];
#pragma unroll
        for (int r = 0; r < 4; ++r) { const int m = m0 + r * NGW; const f32x4* xr = (const f32x4*)(xs + (size_t)((m < MTOK) ? m : m0) * DM) + lane;
#pragma unroll
            for (int j = 0; j < 4; ++j) v[r][j] = __builtin_nontemporal_load(xr + 64 * j); }
#pragma unroll
        for (int r = 0; r < 4; ++r) { const int m = m0 + r * NGW; if (m >= MTOK) break;
            const int b = m >> 12; float ss = 0.f;
#pragma unroll
            for (int j = 0; j < 4; ++j) ss += (v[r][j].x * v[r][j].x + v[r][j].y * v[r][j].y) + (v[r][j].z * v[r][j].z + v[r][j].w * v[r][j].w);
            ss = wave_sum(ss, x32);
            if (lane == 0) rowsq[m] = (unsigned long long)(ss * 4294967296.f);
            unsigned long long* o8 = (unsigned long long*)(h + (size_t)m * DM) + lane;
#pragma unroll
            for (int j = 0; j < 4; ++j) { const int col = 4 * lane + 256 * j;
                const f32x4 g = *(const f32x4*)(gain + col), sc = *(const f32x4*)(mod_l + (size_t)b * 6144 + DM + col);
                const f32x4 y = v[r][j] * (g * (sc + 1.f));
                o8[64 * j] = (unsigned long long)cvtpk(y.x, y.y) | ((unsigned long long)cvtpk(y.z, y.w) << 32); } }
    }
}
DI void bias_phase(const unsigned char* wsb, int NGW, const int wave_s) {
    PHASE_IDS();
    const float* mod = (const float*)(wsb + WS_MOD);
    constexpr int RPL = 3072 + 5632, RTOT = DEPTH * RPL;
    const int chunk = (RTOT + NGW - 1) / NGW;
    const int it0 = gw * chunk, it1 = (it0 + chunk < RTOT) ? it0 + chunk : RTOT;
    int cur = -1;
    f32x4 sh[8][4];
#pragma unroll
    for (int b = 0; b < 8; ++b)
#pragma unroll
        for (int q = 0; q < 4; ++q) sh[b][q] = (f32x4){0.f, 0.f, 0.f, 0.f};
    for (int itb = it0; itb < it1; itb += 4) {
        v4u w0[4], w1[4];
#pragma unroll
        for (int u = 0; u < 4; ++u) { const int it = (itb + u < it1) ? itb + u : it1 - 1; const int l = it / RPL, r = it - l * RPL; const bool first = r < 3072; const int rr = first ? r : r - 3072;
            const bf16* wrow = (const bf16*)(wsb + WS_W + (size_t)l * W_LAYER + (first ? W_IN : W_GU)) + (size_t)rr * DM;
            w0[u] = *(const v4u*)(wrow + 8 * lane); w1[u] = *(const v4u*)(wrow + 512 + 8 * lane); }
#pragma unroll
        for (int u = 0; u < 4; ++u) {
            const int it = itb + u; if (it >= it1) break;
            const int l = it / RPL, r = it - l * RPL, kind = l % 3; const bool first = r < 3072; const int rr = first ? r : r - 3072;
            if (first && kind == 2 && rr >= 1280) continue;
            const int key = l * 2 + (first ? 0 : 1);
            if (key != cur) { cur = key;
#pragma unroll
                for (int b = 0; b < 8; ++b) { const float* sp = mod + (size_t)(l * 8 + b) * 6144 + (first ? 0 : 3 * DM) + 8 * lane;
                    sh[b][0] = *(const f32x4*)sp; sh[b][1] = *(const f32x4*)(sp + 4); sh[b][2] = *(const f32x4*)(sp + 512); sh[b][3] = *(const f32x4*)(sp + 516); } }
            float wf[16];
#pragma unroll
            for (int t = 0; t < 4; ++t) { wf[2 * t] = __builtin_bit_cast(float, w0[u][t] << 16); wf[2 * t + 1] = __builtin_bit_cast(float, w0[u][t] & 0xffff0000u);
                wf[8 + 2 * t] = __builtin_bit_cast(float, w1[u][t] << 16); wf[8 + 2 * t + 1] = __builtin_bit_cast(float, w1[u][t] & 0xffff0000u); }
            float* bout = (float*)(wsb + WS_BIAS + (size_t)l * BIAS_LAYER) + (first ? 0 : 8 * 3072);
            const int ld = first ? 3072 : 5632;
            float res = 0.f;
#pragma unroll
            for (int b = 0; b < 8; ++b) { float d = 0.f;
#pragma unroll
                for (int e = 0; e < 4; ++e) d += sh[b][0][e] * wf[e] + sh[b][1][e] * wf[4 + e] + sh[b][2][e] * wf[8 + e] + sh[b][3][e] * wf[12 + e];
                d = wave_sum(d, x32);
                if (lane == b) res = d; }
            if (lane < 8) bout[(size_t)lane * ld + rr] = res;
        }
    }
}
DI void rope_phase(bf16* qb, unsigned char* kfb, int nkv, const float* gains, bool do_kmean, bf16* kmean, int NGW, const int wave_s) {
    const int nslots = nkv;
    PHASE_IDS();
    const int sub = lane >> 3, j = lane & 7;
    float invf[8];
#pragma unroll
    for (int t = 0; t < 8; ++t) invf[t] = exp2f(-(float)(8 * (j & 3) + t) * (13.287712379549449f / 32.f));
    for (int id = gw; id < NB * 16 * nslots; id += NGW) {
        const int slot = 16 + id % nslots, bn = id / nslots, b = bn >> 4, n = bn & 15;
        float g[8];
#pragma unroll
        for (int t = 0; t < 8; ++t) g[t] = gains[(slot < 16 ? 0 : 64) + 8 * j + t];
        float ksum[8];
#pragma unroll
        for (int t = 0; t < 8; ++t) ksum[t] = 0.f;
        for (int itb = 0; itb < 32; itb += 8) {
            v4u rawv[8]; bf16* ptrv[8];
#pragma unroll
            for (int u = 0; u < 8; ++u) { const int tok = n * 256 + (itb + u) * 8 + sub;
                ptrv[u] = (slot < 16) ? qb + (size_t)(b * SEQ + tok) * 1024 + slot * 64 + 8 * j
                                      : (bf16*)(kfb + ((size_t)((b * nkv + (slot - 16)) * 128 + (tok >> 5)) << 12) + (j >> 1) * 1024 + ((j & 1) * 32 + pg8::pi32(tok & 31)) * 16);
                rawv[u] = *(const v4u*)ptrv[u]; }
#pragma unroll
            for (int u = 0; u < 8; ++u) {
            const int tok = n * 256 + (itb + u) * 8 + sub;
            bf16* ptr = ptrv[u];
            const v4u raw = rawv[u];
            float v[8];
#pragma unroll
            for (int t = 0; t < 4; ++t) { v[2 * t] = __builtin_bit_cast(float, raw[t] << 16); v[2 * t + 1] = __builtin_bit_cast(float, raw[t] & 0xffff0000u); }
            float ss = 0.f;
#pragma unroll
            for (int t = 0; t < 8; ++t) ss += v[t] * v[t];
            ss += swz_xor<1>(ss); ss += swz_xor<2>(ss); ss += swz_xor<4>(ss);
            const float rstd = rsqrtf(ss * (1.f / 64.f) + EPS);
            float o[8];
#pragma unroll
            for (int t = 0; t < 8; ++t) {
                const float vv = v[t] * rstd * g[t];
                const float pv = swz_xor<4>(vv);
                float r = (float)tok * invf[t] * 0.15915494309189535f; r = r - floorf(r);
                const float cs = __builtin_amdgcn_cosf(r), sn = __builtin_amdgcn_sinf(r);
                o[t] = (j < 4) ? (vv * cs - pv * sn) : (vv * cs + pv * sn);
                ksum[t] += o[t];
            }
            v4u w; w.x = cvtpk(o[0], o[1]); w.y = cvtpk(o[2], o[3]); w.z = cvtpk(o[4], o[5]); w.w = cvtpk(o[6], o[7]);
            *(v4u*)ptr = w;
            }
        }
        if (do_kmean && slot >= 16) {
#pragma unroll
            for (int t = 0; t < 8; ++t) { float s = ksum[t]; s += swz_xor<8>(s); s += swz_xor<16>(s); s += bperm(s, x32); ksum[t] = s * (1.f / 256.f); }
            if (sub == 0) { v4u w; w.x = cvtpk(ksum[0], ksum[1]); w.y = cvtpk(ksum[2], ksum[3]); w.z = cvtpk(ksum[4], ksum[5]); w.w = cvtpk(ksum[6], ksum[7]);
                *(v4u*)(kmean + (size_t)((b * 16 + (slot - 16)) * 16 + n) * 64 + 8 * j) = w; }
        }
    }
}
DI f32x16 zero16() { f32x16 z;
#pragma unroll
    for (int i = 0; i < 16; ++i) z[i] = 0.f;
    return z; }
DI void pv_regs(const bf16x8 (&vf)[4], const f32x16& p, f32x16& O0, f32x16& O1) {
    v4u pk; pk.x = cvtpk(p[0], p[1]); pk.y = cvtpk(p[2], p[3]); pk.z = cvtpk(p[4], p[5]); pk.w = cvtpk(p[6], p[7]);
    const bf16x8 pb0 = __builtin_bit_cast(bf16x8, pk);
    pk.x = cvtpk(p[8], p[9]); pk.y = cvtpk(p[10], p[11]); pk.z = cvtpk(p[12], p[13]); pk.w = cvtpk(p[14], p[15]);
    const bf16x8 pb1 = __builtin_bit_cast(bf16x8, pk);
    O0 = MFMA32(vf[0], pb0, O0); O1 = MFMA32(vf[2], pb0, O1);
    O0 = MFMA32(vf[1], pb1, O0); O1 = MFMA32(vf[3], pb1, O1);
}
DI void softmax_update(f32x16& s, float& m_run, float& l_run, f32x16& O0, f32x16& O1, int x32) {
    float tmax = s[0];
#pragma unroll
    for (int i = 1; i < 16; ++i) tmax = fmaxf(tmax, s[i]);
    tmax = fmaxf(tmax, bperm(tmax, x32));
    const float m_new = fmaxf(m_run, tmax);
    const float m_use = (m_new == -INFINITY) ? 0.f : m_new;
    const float alpha = __builtin_amdgcn_exp2f(m_run - m_use);
    float rs = 0.f;
#pragma unroll
    for (int i = 0; i < 16; ++i) { s[i] = __builtin_amdgcn_exp2f(s[i] - m_use); rs += s[i]; }
    rs += bperm(rs, x32);
    l_run = l_run * alpha + rs; m_run = m_new;
    O0 = O0 * alpha; O1 = O1 * alpha;
}
template <int MODE>
DI bool attn_tile(const bf16x8 (&kf)[4], const bf16x8 (&vf)[4], const bf16x8 (&qf)[4], int key0, int q0, int tq, int hi, int x32, int own, unsigned selmask,
                  float& m_run, float& l_run, f32x16& O0, f32x16& O1) {
    f32x16 s = zero16();
#pragma unroll
    for (int kk = 0; kk < 4; ++kk) s = MFMA32(kf[kk], qf[kk], s);
    if constexpr (MODE == 0) {
        float lk[16];
        if (key0 == q0) {
#pragma unroll
            for (int i = 0; i < 16; ++i) {
                const int key = key0 + 16 * (i >> 3) + 8 * hi + (i & 7);
                const bool past = key < tq;
                const float z = s[i] * SC2;
                const float l1 = __builtin_amdgcn_logf(1.f + __builtin_amdgcn_exp2f(-fabsf(z)));
                s[i] = past ? (fminf(z, 0.f) - l1) : -INFINITY;
                lk[i] = past ? -(fmaxf(z, 0.f) + l1) : 0.f;
            }
        } else {
#pragma unroll
            for (int i = 0; i < 16; ++i) {
                const float z = s[i] * SC2;
                const float l1 = __builtin_amdgcn_logf(1.f + __builtin_amdgcn_exp2f(-fabsf(z)));
                s[i] = fminf(z, 0.f) - l1; lk[i] = -(fmaxf(z, 0.f) + l1);
            }
        }
        float s_lo = 0.f, s_hi = 0.f;
#pragma unroll
        for (int i = 0; i < 8; ++i) { s_lo += lk[i]; s_hi += lk[8 + i]; }
        const float p_lo = bperm(s_lo, x32), p_hi = bperm(s_hi, x32);
        const float carry = m_run;
        float off_hi = hi ? carry : carry + p_hi;
        float off_lo = hi ? carry + s_hi + p_hi : carry + p_hi + s_hi + p_lo;
#pragma unroll
        for (int i = 7; i >= 0; --i) { s[8 + i] = __builtin_amdgcn_exp2f(s[8 + i] + off_hi); off_hi += lk[8 + i]; s[i] = __builtin_amdgcn_exp2f(s[i] + off_lo); off_lo += lk[i]; }
        m_run = carry + ((s_lo + s_hi) + (p_lo + p_hi));
        pv_regs(vf, s, O0, O1);
        return __all(m_run < -36.f);
    } else if constexpr (MODE == 2) {
        if (key0 == q0 || key0 + 128 == q0) {
#pragma unroll
            for (int i = 0; i < 16; ++i) { const int key = key0 + 16 * (i >> 3) + 8 * hi + (i & 7);
                s[i] = (key <= tq && key > tq - 128) ? s[i] * SC2 : -INFINITY; }
        } else {
#pragma unroll
            for (int i = 0; i < 16; ++i) s[i] = s[i] * SC2;
        }
        softmax_update(s, m_run, l_run, O0, O1, x32);
        pv_regs(vf, s, O0, O1);
        return false;
    } else {
        const int blk = key0 >> 8; const float B2 = m_run;
        if (key0 == q0) {
#pragma unroll
            for (int i = 0; i < 16; ++i) { const int key = key0 + 16 * (i >> 3) + 8 * hi + (i & 7); const float p = __builtin_amdgcn_exp2f((key <= tq) ? s[i] * SC2 - B2 : -INFINITY); s[i] = p; l_run += p; }
        } else {
            const float bsh = (blk == own || ((selmask >> blk) & 1u)) ? B2 : INFINITY;
#pragma unroll
            for (int i = 0; i < 16; ++i) { const float p = __builtin_amdgcn_exp2f(s[i] * SC2 - bsh); s[i] = p; l_run += p; }
        }
        pv_regs(vf, s, O0, O1);
        return false;
    }
}
DI void rope_q(bf16x8 (&qf)[4], const float* gq, int pos, int hi, int x32) {
    float v[4][8]; float ss = 0.f;
#pragma unroll
    for (int kk = 0; kk < 4; ++kk) { const v4u raw = __builtin_bit_cast(v4u, qf[kk]);
#pragma unroll
        for (int t = 0; t < 4; ++t) { v[kk][2 * t] = __builtin_bit_cast(float, raw[t] << 16); v[kk][2 * t + 1] = __builtin_bit_cast(float, raw[t] & 0xffff0000u); } }
#pragma unroll
    for (int kk = 0; kk < 4; ++kk)
#pragma unroll
        for (int j = 0; j < 8; ++j) ss += v[kk][j] * v[kk][j];
    ss += bperm(ss, x32);
    const float rstd = rsqrtf(ss * (1.f / 64.f) + EPS);
#pragma unroll
    for (int kk = 0; kk < 4; ++kk) { const f32x4 g0 = *(const f32x4*)(gq + 16 * kk + 8 * hi), g1 = *(const f32x4*)(gq + 16 * kk + 8 * hi + 4);
#pragma unroll
        for (int j = 0; j < 4; ++j) { v[kk][j] = v[kk][j] * rstd * g0[j]; v[kk][4 + j] = v[kk][4 + j] * rstd * g1[j]; } }
#pragma unroll
    for (int kk = 0; kk < 2; ++kk)
#pragma unroll
        for (int j = 0; j < 8; ++j) {
            const float invf = exp2f(-(float)(16 * kk + 8 * hi + j) * (13.287712379549449f / 32.f));
            float r = (float)pos * invf * 0.15915494309189535f; r = r - floorf(r);
            const float cs = __builtin_amdgcn_cosf(r), sn = __builtin_amdgcn_sinf(r);
            const float x1 = v[kk][j], x2 = v[kk + 2][j];
            v[kk][j] = x1 * cs - x2 * sn; v[kk + 2][j] = x2 * cs + x1 * sn; }
#pragma unroll
    for (int kk = 0; kk < 4; ++kk) { v4u w; w.x = cvtpk(v[kk][0], v[kk][1]); w.y = cvtpk(v[kk][2], v[kk][3]); w.z = cvtpk(v[kk][4], v[kk][5]); w.w = cvtpk(v[kk][6], v[kk][7]); qf[kk] = __builtin_bit_cast(bf16x8, w); }
}
DI unsigned moba_select(const bf16x8 (&qf)[4], const bf16* kmean, int b, int h, int own, int hi, int col, int x32) {
    unsigned selmask = 0u;
    const char* kmb = (const char*)(kmean + (size_t)((b * 16 + h) * 16) * 64);
    const unsigned kmo = (unsigned)((col & 15) * 64 + 8 * hi) * 2u;
    f32x16 g = zero16();
#pragma unroll
    for (int kk = 0; kk < 4; ++kk) { const bf16x8 kf = *(const bf16x8*)(kmb + kmo + 32 * kk); g = MFMA32(kf, qf[kk], g); }
    float val[8];
    const int own4 = own - 4 * hi;
#pragma unroll
    for (int i = 0; i < 8; ++i) val[i] = ((i & 3) + 8 * (i >> 2) < own4) ? g[i] : -INFINITY;
    float lv[3]; int ln[3];
#pragma unroll
    for (int r = 0; r < 3; ++r) { float best = -INFINITY; int bi = 8;
#pragma unroll
        for (int i = 0; i < 8; ++i) if (val[i] > best) { best = val[i]; bi = i; }
#pragma unroll
        for (int i = 0; i < 8; ++i) if (bi == i) val[i] = -INFINITY;
        lv[r] = best; ln[r] = (bi < 8) ? ((bi & 3) + 8 * (bi >> 2) + 4 * hi) : 99; }
    float cv[6]; int cn[6];
#pragma unroll
    for (int r = 0; r < 3; ++r) { const float pv = bperm(lv[r], x32); const int pn = bperm_i(ln[r], x32);
        cv[r] = hi ? pv : lv[r]; cn[r] = hi ? pn : ln[r]; cv[3 + r] = hi ? lv[r] : pv; cn[3 + r] = hi ? ln[r] : pn; }
#pragma unroll
    for (int r = 0; r < 3; ++r) { float best = -INFINITY; int bi = 6;
#pragma unroll
        for (int i = 0; i < 6; ++i) if (cv[i] > best) { best = cv[i]; bi = i; }
        int bn = 99;
#pragma unroll
        for (int i = 0; i < 6; ++i) if (bi == i) { cv[i] = -INFINITY; bn = cn[i]; }
        if (bn < 16) selmask |= 1u << bn; }
    return selmask;
}
DI void moba_wg_phase(const bf16* qb, const unsigned char* kfb, const unsigned char* vfb, bf16* ob, const bf16* kmean, const float* gains, int G, LAS unsigned char* lds, const int wave_s) {
    PHASE_IDS();
    float B2;
    { float a = fabsf(gains[lane]), c = fabsf(gains[64 + lane]);
      a = fmaxf(a, swz_xor<1>(a)); a = fmaxf(a, swz_xor<2>(a)); a = fmaxf(a, swz_xor<4>(a)); a = fmaxf(a, swz_xor<8>(a)); a = fmaxf(a, swz_xor<16>(a)); a = fmaxf(a, bperm(a, x32));
      c = fmaxf(c, swz_xor<1>(c)); c = fmaxf(c, swz_xor<2>(c)); c = fmaxf(c, swz_xor<4>(c)); c = fmaxf(c, swz_xor<8>(c)); c = fmaxf(c, swz_xor<16>(c)); c = fmaxf(c, bperm(c, x32));
      B2 = 1.02f * 8.f * 1.4426950408889634f * a * c; }
    const int nx = (G % 8 == 0) ? 8 : 1, per = G / nx, upx = 2048 / nx;
    const int xx = (nx == 8) ? ((int)blockIdx.x & 7) : 0, gi = (nx == 8) ? ((int)blockIdx.x >> 3) : (int)blockIdx.x;
    const unsigned wpiece = (unsigned)(wave >> 2) * 4096u + (unsigned)(wave & 3) * 1024u;
    for (int v = gi; v < upx; v += per) {
        int lane_u = lane; asm volatile("" : "+v"(lane_u));
        const int hi = lane_u >> 5, col = lane_u & 31, xq = (lane_u ^ 32) << 2; const unsigned lofs = (unsigned)lane_u * 16u;
        const int it = v / per, own = (v + it) & 15, bh = xx * (128 / nx) + (v >> 4), b = bh >> 4, h = bh & 15;
        const int tok0 = b * SEQ, q0 = own * 256 + 32 * wave, tq = q0 + col;
        const char* gsrc = (const char*)((wave < 4) ? kfb : vfb) + ((size_t)((b * 16 + h) * 128) << 12) + (unsigned)(wave & 3) * 1024u + lofs;
        const int nt = 8 * own + 8;
#define MW_DMA_BLK(blkidx, buf) do { _Pragma("unroll") for (int z_ = 0; z_ < 8; ++z_) \
            __builtin_amdgcn_global_load_lds((const unsigned*)(gsrc + (size_t)((blkidx) * 8 + z_) * 4096), (LAS unsigned*)(lds + (unsigned)(buf) * 65536u + (unsigned)z_ * 8192u + wpiece), 16, 0, 0); } while (0)
        MW_DMA_BLK(0, 0);
        bf16x8 qf[4];
        { const bf16* qp = qb + (size_t)(tok0 + tq) * 1024 + h * 64 + 8 * hi;
#pragma unroll
          for (int kk = 0; kk < 4; ++kk) qf[kk] = *(const bf16x8*)(qp + 16 * kk); }
        rope_q(qf, gains, tq, hi, xq);
        const unsigned selmask = moba_select(qf, kmean, b, h, own, hi, col, xq);
        unsigned anym = 0u;
        for (int n = 0; n < own; ++n) if (__any((selmask >> n) & 1u)) anym |= 1u << n;
        anym = __builtin_amdgcn_readfirstlane(anym);
        f32x16 O0 = zero16(), O1 = zero16(); float m_run = B2, l_run = 0.f;
        for (int n = 0; n <= own; ++n) {
            asm volatile("s_waitcnt vmcnt(0)" ::: "memory");
            __builtin_amdgcn_s_barrier();
            if (n < own) MW_DMA_BLK(n + 1, (n + 1) & 1);
            const bool need = (n < own) ? (((anym >> n) & 1u) != 0u) : true;
            if (need) { const int ntile = (n < own) ? 8 : (wave + 1);
                for (int t = 0; t < ntile; ++t) {
                    const LAS unsigned char* sl = lds + (unsigned)(n & 1) * 65536u + (unsigned)t * 8192u + lofs; bf16x8 kf[4], vf[4];
                    kf[0] = *(const LAS bf16x8*)(sl); kf[1] = *(const LAS bf16x8*)(sl + 1024); kf[2] = *(const LAS bf16x8*)(sl + 2048); kf[3] = *(const LAS bf16x8*)(sl + 3072);
                    vf[0] = *(const LAS bf16x8*)(sl + 4096); vf[1] = *(const LAS bf16x8*)(sl + 5120); vf[2] = *(const LAS bf16x8*)(sl + 6144); vf[3] = *(const LAS bf16x8*)(sl + 7168);
                    (void)attn_tile<1>(kf, vf, qf, n * 256 + 32 * t, q0, tq, hi, xq, own, selmask, m_run, l_run, O0, O1); } }
        }
#undef MW_DMA_BLK
        l_run += bperm(l_run, xq);
        const float inv_l = 1.f / l_run;
        bf16* op = ob + (size_t)(tok0 + tq) * DM + h * 64 + 4 * hi;
#pragma unroll
        for (int g = 0; g < 4; ++g) { uint2 w0, w1;
            w0.x = cvtpk(O0[4 * g] * inv_l, O0[4 * g + 1] * inv_l); w0.y = cvtpk(O0[4 * g + 2] * inv_l, O0[4 * g + 3] * inv_l);
            w1.x = cvtpk(O1[4 * g] * inv_l, O1[4 * g + 1] * inv_l); w1.y = cvtpk(O1[4 * g + 2] * inv_l, O1[4 * g + 3] * inv_l);
            *(uint2*)(op + 8 * g) = w0; *(uint2*)(op + 32 + 8 * g) = w1; }
        __builtin_amdgcn_s_barrier();
    }
}
DI void swa_tile_sf(const bf16x8 (&kf)[4], const bf16x8 (&vf)[4], const bf16x8 (&qf)[4], int key0, int q0, int tq, int hi, float B2, float& l_run, f32x16& O0, f32x16& O1) {
    f32x16 s = zero16();
#pragma unroll
    for (int kk = 0; kk < 4; ++kk) s = MFMA32(kf[kk], qf[kk], s);
    if (key0 == q0 || key0 + 128 == q0) {
#pragma unroll
        for (int i = 0; i < 16; ++i) { const int key = key0 + 16 * (i >> 3) + 8 * hi + (i & 7);
            const float p = __builtin_amdgcn_exp2f((key <= tq && key > tq - 128) ? s[i] * SC2 - B2 : -INFINITY); s[i] = p; l_run += p; }
    } else {
#pragma unroll
        for (int i = 0; i < 16; ++i) { const float p = __builtin_amdgcn_exp2f(s[i] * SC2 - B2); s[i] = p; l_run += p; }
    }
    pv_regs(vf, s, O0, O1);
}
DI void swa_wg_phase(const bf16* qb, const unsigned char* kfb, const unsigned char* vfb, bf16* ob, const float* sinks, const float* gains, int G, LAS unsigned char* lds, const int wave_s) {
    PHASE_IDS();
    float B2;
    { float a = fabsf(gains[lane]), c = fabsf(gains[64 + lane]);
      a = fmaxf(a, swz_xor<1>(a)); a = fmaxf(a, swz_xor<2>(a)); a = fmaxf(a, swz_xor<4>(a)); a = fmaxf(a, swz_xor<8>(a)); a = fmaxf(a, swz_xor<16>(a)); a = fmaxf(a, bperm(a, x32));
      c = fmaxf(c, swz_xor<1>(c)); c = fmaxf(c, swz_xor<2>(c)); c = fmaxf(c, swz_xor<4>(c)); c = fmaxf(c, swz_xor<8>(c)); c = fmaxf(c, swz_xor<16>(c)); c = fmaxf(c, bperm(c, x32));
      B2 = 1.02f * 8.f * 1.4426950408889634f * a * c; }
    const unsigned wpiece = (unsigned)(wave >> 2) * 4096u + (unsigned)(wave & 3) * 1024u;
    for (int sidx = (int)blockIdx.x; sidx < 256; sidx += G) {
        int lane_u = lane; asm volatile("" : "+v"(lane_u));
        const int hi = lane_u >> 5, col = lane_u & 31, xq = (lane_u ^ 32) << 2; const unsigned lofs = (unsigned)lane_u * 16u;
        const int pair = sidx >> 4, b = pair >> 1, kvh = pair & 1, qcs = (sidx & 15) * 8, h = kvh * 8 + wave, tok0 = b * SEQ;
        const char* gsrc = (const char*)((wave < 4) ? kfb : vfb) + ((size_t)((b * 2 + kvh) * 128) << 12) + (unsigned)(wave & 3) * 1024u + lofs;
#define SW_DMA(tile) __builtin_amdgcn_global_load_lds((const unsigned*)(gsrc + (size_t)(tile) * 4096), (LAS unsigned*)(lds + (unsigned)((tile) & 7) * 8192u + wpiece), 16, 0, 0)
        const int tlo = (qcs >= 4) ? qcs - 4 : 0;
        for (int t = tlo; t <= qcs; ++t) SW_DMA(t);
        const float sink2 = sinks[h] * 1.4426950408889634f;
        const bf16* qrow = qb + (size_t)(tok0 + qcs * 32 + col) * 1024 + h * 64 + 8 * hi;
        bf16x8 qf[4];
#pragma unroll
        for (int kk = 0; kk < 4; ++kk) qf[kk] = *(const bf16x8*)(qrow + 16 * kk);
        for (int u = 0; u < 8; ++u) {
            const int qc = qcs + u, q0 = qc * 32, tq = q0 + col;
            asm volatile("s_waitcnt vmcnt(0)" ::: "memory");
            __builtin_amdgcn_s_barrier();
            if (u < 7) SW_DMA(qc + 1);
            bf16x8 qn[4];
#pragma unroll
            for (int kk = 0; kk < 4; ++kk) qn[kk] = *(const bf16x8*)(qrow + (size_t)((u < 7) ? 32 * (u + 1) : 32 * u) * 1024 + 16 * kk);
            rope_q(qf, gains, tq, hi, xq);
            f32x16 O0 = zero16(), O1 = zero16(); float l_run = 0.f;
            for (int t = (qc >= 4) ? qc - 4 : 0; t <= qc; ++t) {
                const LAS unsigned char* sl = lds + (unsigned)(t & 7) * 8192u + lofs; bf16x8 kf[4], vf[4];
                kf[0] = *(const LAS bf16x8*)(sl); kf[1] = *(const LAS bf16x8*)(sl + 1024); kf[2] = *(const LAS bf16x8*)(sl + 2048); kf[3] = *(const LAS bf16x8*)(sl + 3072);
                vf[0] = *(const LAS bf16x8*)(sl + 4096); vf[1] = *(const LAS bf16x8*)(sl + 5120); vf[2] = *(const LAS bf16x8*)(sl + 6144); vf[3] = *(const LAS bf16x8*)(sl + 7168);
                swa_tile_sf(kf, vf, qf, 32 * t, q0, tq, hi, B2, l_run, O0, O1); }
            l_run += bperm(l_run, xq);
            const float inv_l = 1.f / (l_run + __builtin_amdgcn_exp2f(sink2 - B2));
            bf16* op = ob + (size_t)(tok0 + tq) * DM + h * 64 + 4 * hi;
#pragma unroll
            for (int g = 0; g < 4; ++g) { uint2 w0, w1;
                w0.x = cvtpk(O0[4 * g] * inv_l, O0[4 * g + 1] * inv_l); w0.y = cvtpk(O0[4 * g + 2] * inv_l, O0[4 * g + 3] * inv_l);
                w1.x = cvtpk(O1[4 * g] * inv_l, O1[4 * g + 1] * inv_l); w1.y = cvtpk(O1[4 * g + 2] * inv_l, O1[4 * g + 3] * inv_l);
                *(uint2*)(op + 8 * g) = w0; *(uint2*)(op + 32 + 8 * g) = w1; }
#pragma unroll
            for (int kk = 0; kk < 4; ++kk) qf[kk] = qn[kk];
        }
#undef SW_DMA
        asm volatile("s_waitcnt vmcnt(0)" ::: "memory");
        __builtin_amdgcn_s_barrier();
    }
}
DI void sb_wg_phase(const bf16* qb, const unsigned char* kfb, const unsigned char* vfb, bf16* ob, int G, LAS unsigned char* lds, const int wave_s) {
    PHASE_IDS();
    const unsigned wpiece = (unsigned)(wave >> 2) * 4096u + (unsigned)(wave & 3) * 1024u;
    const int nx = (G % 8 == 0) ? 8 : 1, per = G / nx, upx = 2048 / nx;
    const int xx = (nx == 8) ? ((int)blockIdx.x & 7) : 0, gi = (nx == 8) ? ((int)blockIdx.x >> 3) : (int)blockIdx.x;
    for (int v = gi; v < upx; v += per) {
        int lane_u = lane; asm volatile("" : "+v"(lane_u));
        const int hi = lane_u >> 5, col = lane_u & 31, xq = (lane_u ^ 32) << 2; const unsigned lofs = (unsigned)lane_u * 16u;
        const int bh = xx * (128 / nx) + (v >> 4), b = bh >> 4, h = bh & 15, qc0 = (v & 15) * 8, qc = qc0 + wave, q0 = 32 * qc, tq = q0 + col, tok0 = b * SEQ;
        const size_t hbase = (size_t)((b * 16 + h) * 128) << 12;
        const char* gsrc = (const char*)((wave < 4) ? kfb : vfb) + hbase + (unsigned)(wave & 3) * 1024u + lofs;
        const int tlo = (qc0 >= 8) ? qc0 - 8 : 0;
        for (int t = tlo; t < qc0 + 8; ++t)
            __builtin_amdgcn_global_load_lds((const unsigned*)(gsrc + (size_t)t * 4096), (LAS unsigned*)(lds + (unsigned)(t & 15) * 8192u + wpiece), 16, 0, 0);
        bf16x8 qf[4];
        { const bf16* qp = qb + (size_t)(tok0 + tq) * 1024 + h * 64 + 8 * hi;
#pragma unroll
          for (int kk = 0; kk < 4; ++kk) qf[kk] = *(const bf16x8*)(qp + 16 * kk); }
        asm volatile("s_waitcnt vmcnt(0)" ::: "memory");
        __builtin_amdgcn_s_barrier();
        f32x16 O0 = zero16(), O1 = zero16(); float carry = 0.f, lr = 0.f;
        for (int t = qc; t >= 0; --t) {
            bf16x8 kf[4], vf[4];
            if (t >= tlo) { const LAS unsigned char* sl = lds + (unsigned)(t & 15) * 8192u + lofs;
                kf[0] = *(const LAS bf16x8*)(sl); kf[1] = *(const LAS bf16x8*)(sl + 1024); kf[2] = *(const LAS bf16x8*)(sl + 2048); kf[3] = *(const LAS bf16x8*)(sl + 3072);
                vf[0] = *(const LAS bf16x8*)(sl + 4096); vf[1] = *(const LAS bf16x8*)(sl + 5120); vf[2] = *(const LAS bf16x8*)(sl + 6144); vf[3] = *(const LAS bf16x8*)(sl + 7168); }
            else { const char* kb_ = (const char*)kfb + hbase + ((size_t)t << 12) + lofs; const char* vb_ = (const char*)vfb + hbase + ((size_t)t << 12) + lofs;
                kf[0] = *(const bf16x8*)(kb_); kf[1] = *(const bf16x8*)(kb_ + 1024); kf[2] = *(const bf16x8*)(kb_ + 2048); kf[3] = *(const bf16x8*)(kb_ + 3072);
                vf[0] = *(const bf16x8*)(vb_); vf[1] = *(const bf16x8*)(vb_ + 1024); vf[2] = *(const bf16x8*)(vb_ + 2048); vf[3] = *(const bf16x8*)(vb_ + 3072); }
            if (attn_tile<0>(kf, vf, qf, 32 * t, q0, tq, hi, xq, 0, 0u, carry, lr, O0, O1)) break;
        }
        bf16* op = ob + (size_t)(tok0 + tq) * DM + h * 64 + 4 * hi;
#pragma unroll
        for (int g = 0; g < 4; ++g) { uint2 w0, w1;
            w0.x = cvtpk(O0[4 * g], O0[4 * g + 1]); w0.y = cvtpk(O0[4 * g + 2], O0[4 * g + 3]);
            w1.x = cvtpk(O1[4 * g], O1[4 * g + 1]); w1.y = cvtpk(O1[4 * g + 2], O1[4 * g + 3]);
            *(uint2*)(op + 8 * g) = w0; *(uint2*)(op + 32 + 8 * g) = w1; }
        __builtin_amdgcn_s_barrier();
    }
}
__global__ void __launch_bounds__(NTHREADS, 2) trunk_fwd(Params p) {
    extern __shared__ __attribute__((aligned(16))) unsigned char lds_raw[];
    cg::grid_group grid = cg::this_grid();
    LAS unsigned char* lds = (LAS unsigned char*)lds_raw;
    const int tid = threadIdx.x, lane = tid & 63, wave = __builtin_amdgcn_readfirstlane(tid >> 6); const int wave_s = wave;
    const int G = gridDim.x, gw = blockIdx.x * NWAVES + wave, NGW = G * NWAVES;
    unsigned char* ws0 = p.ws;
#define ws (KP()->ws)
#define mod ((float*)(ws + WS_MOD))
#define kmean ((bf16*)(ws + WS_KMEAN))
#define HB ((bf16*)(ws + WS_H))
#define OB ((bf16*)(ws + WS_O))
#define QK ((bf16*)(ws + WS_QK))
#define VT ((bf16*)(ws + WS_VT))
#define ACT ((bf16*)(ws + WS_ACT))

    if (tid < 8) ((volatile LAS unsigned*)(lds + MISC_OFF))[tid] = 0u;
    __syncthreads();
    const XcdBarrier bar = xcd_barrier_post((unsigned*)(ws0 + WS_BAR), (volatile LAS unsigned*)(lds + MISC_OFF));
#define GSYNC() do { int l_; asm volatile("v_mbcnt_lo_u32_b32 %0, -1, 0\n\tv_mbcnt_hi_u32_b32 %0, -1, %0" : "=v"(l_)); xcd_barrier(bar, (wave_s * 64 + l_) == 0); } while (0)
    mod_phase(p, lds, tid, wave, lane, G);
    __syncthreads();
    weights_phase(p, lds, gw, NGW, wave, lane);
    { unsigned long long* rsq = (unsigned long long*)(ws0 + WS_RSQ) + MTOK;
      for (int i = (int)blockIdx.x * NTHREADS + tid; i < 7 * MTOK; i += G * NTHREADS) rsq[i] = 0ull; }
    if (gridDim.y == 0x7fffu) grid.sync();
    GSYNC();
    xs0_phase(KP()->x, KP()->norm_gain, mod, HB, (unsigned long long*)(ws + WS_RSQ), NGW, wave_s);
    bias_phase(ws, NGW, wave_s);
    GSYNC();

#pragma unroll 1
    for (int l = 0; l < DEPTH; ++l) {
        const int kind = l % 3;
        const float* mod_l = mod + (size_t)l * 8 * 6144;
        const bf16* wl = (const bf16*)(ws + WS_W + (size_t)l * W_LAYER);
        const int nqkv = (kind == 2) ? 1280 : 3072, nqk = (kind == 2) ? 1280 : 2048;
        const unsigned long long* rsq1 = (const unsigned long long*)(ws + WS_RSQ) + (size_t)(2 * l) * MTOK;
        const float* bias1 = (const float*)(ws + WS_BIAS + (size_t)l * BIAS_LAYER);
        const int nkv = (kind == 2) ? 2 : 16;
        {
            pg8::Gemm g{HB, wl + W_IN / 2, MTOK, nqk, DM}; pg8::StaticOrder S; S.init(MTOK, nqk, G, (int)blockIdx.x);
            pg8::EpiQK E{QK, ws + WS_KF, nkv, rsq1, bias1, 3072};
            pg8::gemm_phase<pg8::EpiQK, pg8::StaticOrder, true, true>(lds, g, S, E, wave_s);
        }
        {
            const int vrows = (kind == 2) ? 256 : 1024;
            pg8::Gemm g{wl + W_IN / 2 + (size_t)(nqkv - vrows) * DM, HB, vrows, MTOK, DM}; pg8::StaticOrder S; S.init(vrows, MTOK, G, (int)blockIdx.x);
            pg8::EpiVT E{ws + WS_VT, nkv, (kind == 2) ? 128 : 0, rsq1, bias1 + (nqkv - vrows), 3072};
            pg8::gemm_phase<pg8::EpiVT, pg8::StaticOrder, true, true>(lds, g, S, E, wave_s);
        }
        GSYNC();
        if (kind != 0) {
            rope_phase(QK, ws + WS_KF, nkv, kind == 1 ? KP()->moba_gain : KP()->swa_gain, kind == 1, kmean, NGW, wave_s);
            GSYNC();
        }
        if (kind == 0) sb_wg_phase(QK, ws + WS_KF, ws + WS_VT, OB, G, lds, wave_s);
        else if (kind == 1) moba_wg_phase(QK, ws + WS_KF, ws + WS_VT, OB, kmean, KP()->moba_gain, G, lds, wave_s);
        else swa_wg_phase(QK, ws + WS_KF, ws + WS_VT, OB, KP()->swa_sinks, KP()->swa_gain, G, lds, wave_s);
        GSYNC();
        {
            const bf16* wo = wl + W_OUT / 2;
            pg8::Gemm g{OB, wo, MTOK, DM, DM}; pg8::StaticOrder S; S.init(MTOK, DM, G, (int)blockIdx.x);
            pg8::EpiRes E{HB, KP()->norm_gain + (size_t)(l * 2) * DM, mod_l + DM, mod_l + 2 * DM, (float*)nullptr, HB, KP()->norm_gain + (size_t)(l * 2 + 1) * DM, mod_l + 4 * DM, (unsigned long long*)(ws + WS_RSQ) + (size_t)(2 * l + 1) * MTOK};
            pg8::gemm_phase<pg8::EpiRes, pg8::StaticOrder, true, true>(lds, g, S, E, wave_s);
        }
        GSYNC();
        {
            pg8::Gemm g{HB, wl + W_GU / 2, MTOK, 2 * FF, DM}; pg8::StaticOrder S; S.init(MTOK, 2 * FF, G, (int)blockIdx.x);
            pg8::EpiGLU E{ACT, FF, (const unsigned long long*)(ws + WS_RSQ) + (size_t)(2 * l + 1) * MTOK, bias1 + 8 * 3072};
            pg8::gemm_phase<pg8::EpiGLU, pg8::StaticOrder, true, true>(lds, g, S, E, wave_s);
        }
        GSYNC();
        {
            const bool more = (l + 1 < DEPTH);
            pg8::Gemm g{ACT, wl + W_DN / 2, MTOK, DM, FF}; pg8::StaticOrder S; S.init(MTOK, DM, G, (int)blockIdx.x);
            pg8::EpiRes E{HB, KP()->norm_gain + (size_t)(l * 2 + 1) * DM, mod_l + 4 * DM, mod_l + 5 * DM, more ? (float*)nullptr : KP()->out, more ? HB : (bf16*)nullptr, KP()->norm_gain + (size_t)((l + 1) * 2) * DM, mod_l + 8 * 6144 + DM, (unsigned long long*)(ws + WS_RSQ) + (size_t)(2 * l + 2) * MTOK};
            pg8::gemm_phase<pg8::EpiRes, pg8::StaticOrder, true, true>(lds, g, S, E, wave_s);
        }
        if (l + 1 < DEPTH) GSYNC();
    }
}
#undef ws
#undef mod
#undef kmean
#undef HB
#undef OB
#undef QK
#undef VT
#undef ACT
extern "C" void kernel_launch(void* const* d_in, const int* in_sizes, int n_in, void* d_out, int out_size, void* d_ws, size_t ws_size, hipStream_t stream) {
    static int grid = 0;
    if (grid == 0) {
        if (n_in != 17 || out_size != MTOK * DM || ws_size < WS_END) { fprintf(stderr, "kernel_launch: unexpected shapes (n_in %d out %d ws %zu)\n", n_in, out_size, ws_size); grid = -1; return; }
        int dev = 0, cus = 0, per_cu = 0;
        hipGetDevice(&dev); hipDeviceGetAttribute(&cus, hipDeviceAttributeMultiprocessorCount, dev);
        if (hipFuncSetAttribute((const void*)trunk_fwd, hipFuncAttributeMaxDynamicSharedMemorySize, LDS_BYTES) != hipSuccess) { fprintf(stderr, "kernel_launch: hipFuncSetAttribute failed\n"); grid = -1; return; }
        if (hipOccupancyMaxActiveBlocksPerMultiprocessor(&per_cu, (const void*)trunk_fwd, NTHREADS, LDS_BYTES) != hipSuccess || per_cu < 1) { fprintf(stderr, "kernel_launch: occupancy query failed (%d)\n", per_cu); (void)hipGetLastError(); per_cu = 1; }
        grid = cus * per_cu;
    }
    if (grid < 0) return;
    Params p{};
    const float** pp = (const float**)&p;
    for (int i = 0; i < 17; ++i) pp[i] = (const float*)d_in[i];
    p.out = (float*)d_out; p.ws = (unsigned char*)d_ws;
    if (hipMemsetAsync((char*)d_ws + WS_BAR, 0, 16384, stream) != hipSuccess) { fprintf(stderr, "kernel_launch: memset failed\n"); return; }
    void* args[] = {&p};
    hipError_t e = hipLaunchCooperativeKernel((const void*)trunk_fwd, dim3(grid), dim3(NTHREADS), args, LDS_BYTES, stream);
    if (e != hipSuccess) fprintf(stderr, "cooperative launch failed: %s (grid %d)\n", hipGetErrorString(e), grid);
}
```
